# Optimizing an MI355X kernel written in HIP

```python
import math
import jax
import jax.numpy as jnp
from jax import lax
import numpy as np

D_MODEL = 1024
BATCH = 16
SEQ = 4096
DEPTH = 1

CTX_LEN = 256
GRID_W = 64
H_M = 8
D_HM = 64
W_M = H_M * D_HM
H_R = 8
D_HR = 64
W_R = H_R * D_HR
MIX_W = W_M + W_R
W_LORA = 64
A_LORA = 64
G_LORA = 128
CONV_K = 3
CONV_CH = 2 * W_M + 3 * W_R
SECTION_WIDTHS = (W_M, W_M, W_R, W_R, W_R, W_M, W_M, 4 * H_M, W_LORA, W_LORA, A_LORA, G_LORA)
IN_COLS = sum(SECTION_WIDTHS)
SPLIT_POINTS = tuple(int(v) for v in np.cumsum(SECTION_WIDTHS)[:-1])
CHUNK = 64
N_GROUPS = 4
E_PER_GROUP = 8
N_EXPERTS = N_GROUPS * E_PER_GROUP
TOP_K_IN_GROUP = 2
D_EXPERT = 512
MOE_BLOCK = 256
ALPHA = (2.0 * DEPTH) ** 0.25
BETA = (8.0 * DEPTH) ** -0.25
DECAY_SCALE = math.exp(-0.5)
LN_EPS = 1e-6
GN_EPS = 64e-5

kernel_name = 'hybrid_mlstm_rwkv7_hmoe_dit'


def _layernorm(z, gain=None, bias=None):
    zf = z.astype(jnp.float32)
    mu = jnp.mean(zf, -1, keepdims=True)
    var = jnp.mean(jnp.square(zf - mu), -1, keepdims=True)
    y = (zf - mu) * lax.rsqrt(var + LN_EPS)
    if gain is not None:
        y = y * gain + bias
    return y.astype(z.dtype)


def _headnorm(z, eps):
    zf = z.astype(jnp.float32)
    mu = jnp.mean(zf, -1, keepdims=True)
    var = jnp.mean(jnp.square(zf - mu), -1, keepdims=True)
    return (zf - mu) * lax.rsqrt(var + eps)


def _modulate(z, shift, scale):
    return _layernorm(z) * (1 + scale) + shift


def _rev_segments(u):
    return jnp.concatenate([jnp.flip(u[:, :CTX_LEN], 1), jnp.flip(u[:, CTX_LEN:], 1)], axis=1)


def _dir_stack(u_fwd, u_bwd):
    return jnp.concatenate([u_fwd, _rev_segments(u_bwd)], axis=0)


def _dir_merge(y):
    b = y.shape[0] // 2
    return y[:b] + _rev_segments(y[b:])


def _conv_grid(u, w, rows):
    b, l, ch = u.shape
    img = u.reshape(b, rows, l // rows, ch)
    out = lax.conv_general_dilated(img, w[:, :, None, :].astype(u.dtype), (1, 1), 'SAME',
                                   dimension_numbers=('NHWC', 'HWIO', 'NHWC'), feature_group_count=ch)
    return out.reshape(b, l, ch)


def _conv_seq(u, w_row):
    ch = u.shape[-1]
    return lax.conv_general_dilated(u, w_row[:, None, :].astype(u.dtype), (1,), 'SAME',
                                    dimension_numbers=('NWC', 'WIO', 'NWC'), feature_group_count=ch)


def _mlstm_chunkwise(q, k, v, log_i, log_f):
    z, t, h, dh = q.shape
    nc = t // CHUNK
    def chunks(a):
        a = a.astype(jnp.float32).reshape((z, nc, CHUNK, h) + a.shape[3:])
        return jnp.swapaxes(jnp.swapaxes(a, 0, 1), 2, 3)
    qc, kc, vc, lic, lfc = chunks(q), chunks(k), chunks(v), chunks(log_i), chunks(log_f)
    tri = jnp.tril(jnp.ones((CHUNK, CHUNK), bool))

    def step(carry, inp):
        c_mat, n_vec, m = carry
        qb, kb, vb, li, lf = inp
        b = jnp.cumsum(lf, -1)
        dmat = jnp.where(tri, b[..., :, None] - b[..., None, :] + li[..., None, :], -jnp.inf)
        m_inter = b + m[..., None]
        m_t = jnp.maximum(m_inter, jnp.max(dmat, -1))
        s = jnp.einsum('zhtd,zhsd->zhts', qb, kb) * jnp.exp(dmat - m_t[..., None])
        inter = jnp.exp(m_inter - m_t)
        num = inter[..., None] * jnp.einsum('zhtd,zhde->zhte', qb, c_mat) + jnp.einsum('zhts,zhse->zhte', s, vb)
        den = inter * jnp.einsum('zhtd,zhd->zht', qb, n_vec) + jnp.sum(s, -1)
        h_out = num / jnp.maximum(jnp.abs(den), jnp.exp(-m_t))[..., None]
        b_last = b[..., -1]
        g = b_last[..., None] - b + li
        m_new = jnp.maximum(b_last + m, jnp.max(g, -1))
        wts = jnp.exp(g - m_new[..., None])
        decay = jnp.exp(b_last + m - m_new)
        c_mat = decay[..., None, None] * c_mat + jnp.einsum('zhs,zhsd,zhse->zhde', wts, kb, vb)
        n_vec = decay[..., None] * n_vec + jnp.einsum('zhs,zhsd->zhd', wts, kb)
        return (c_mat, n_vec, m_new), h_out

    init = (jnp.zeros((z, h, dh, dh), jnp.float32), jnp.zeros((z, h, dh), jnp.float32), jnp.zeros((z, h), jnp.float32))
    _, hs = lax.scan(step, init, (qc, kc, vc, lic, lfc))
    return jnp.swapaxes(jnp.swapaxes(hs, 2, 3), 0, 1).reshape(z, t, h, dh)


def _mlstm_group(mq, mk, mv, mo, gates, b_i, b_f, norm_w):
    b, t, _ = mq.shape
    q = jax.nn.silu(mq).reshape(b, t, H_M, D_HM)
    k = jax.nn.silu(mk).reshape(b, t, H_M, D_HM) * (D_HM ** -0.5)
    v = mv.reshape(b, t, H_M, D_HM)
    gt = gates.astype(jnp.float32).reshape(b, t, 4, H_M)
    li_f = gt[:, :, 0] + b_i[0]
    lf_f = jax.nn.log_sigmoid(gt[:, :, 1] + b_f[0])
    li_b = gt[:, :, 2] + b_i[1]
    lf_b = jax.nn.log_sigmoid(gt[:, :, 3] + b_f[1])
    h = _mlstm_chunkwise(_dir_stack(q, q), _dir_stack(k, k), _dir_stack(v, v),
                         _dir_stack(li_f, li_b), _dir_stack(lf_f, lf_b))
    h = _headnorm(_dir_merge(h), LN_EPS) * norm_w.reshape(H_M, D_HM)
    return jax.nn.sigmoid(mo) * h.reshape(b, t, W_M)


def _rwkv7_scan(r, w, k, v, kh, a):
    z, t, h, n = r.shape
    seq = tuple(jnp.moveaxis(s.astype(jnp.float32), 1, 0) for s in (r, w, k, v, kh, a))

    def step(state, inp):
        r_t, w_t, k_t, v_t, kh_t, a_t = inp
        removed = jnp.einsum('zhvk,zhk->zhv', state, kh_t)
        state = (state * w_t[:, :, None, :] - removed[..., None] * (kh_t * a_t)[:, :, None, :]
                 + v_t[..., None] * k_t[:, :, None, :])
        return state, jnp.einsum('zhvk,zhk->zhv', state, r_t)

    _, y = lax.scan(step, jnp.zeros((z, h, n, n), jnp.float32), seq)
    return jnp.moveaxis(y, 0, 1)


def _rwkv7_group(rr, rk, rv, lw_f, lw_b, la, lg, w0, w_b_mat, a0, a_b_mat, g_b_mat, kk, ka, bonus_w, gn_w, gn_b):
    b, t, _ = rr.shape
    shp = (b, t, H_R, D_HR)
    w_fwd = jnp.exp(-DECAY_SCALE * jax.nn.sigmoid((w0[0] + jnp.tanh(lw_f) @ w_b_mat[0]).astype(jnp.float32)))
    w_bwd = jnp.exp(-DECAY_SCALE * jax.nn.sigmoid((w0[1] + jnp.tanh(lw_b) @ w_b_mat[1]).astype(jnp.float32)))
    a = jax.nn.sigmoid(a0 + la @ a_b_mat)
    g = jax.nn.sigmoid(lg) @ g_b_mat
    kap = (rk * kk).reshape(shp).astype(jnp.float32)
    kh = kap / jnp.maximum(jnp.sqrt(jnp.sum(jnp.square(kap), -1, keepdims=True)), 1e-12)
    kmod = (rk * (1 + (a - 1) * ka)).reshape(shp)
    r = rr.reshape(shp)
    v = rv.reshape(shp)
    a_h = a.reshape(shp)
    y = _rwkv7_scan(_dir_stack(r, r), _dir_stack(w_fwd.reshape(shp), w_bwd.reshape(shp)), _dir_stack(kmod, kmod),
                    _dir_stack(v, v), _dir_stack(kh, kh), _dir_stack(a_h, a_h))
    y = _headnorm(_dir_merge(y), GN_EPS) * gn_w.reshape(H_R, D_HR) + gn_b.reshape(H_R, D_HR)
    bonus = jnp.sum(r * kmod * bonus_w, -1, keepdims=True) * v
    return (y + bonus).reshape(b, t, W_R) * g


def _mixer(h_ctx, h_lat, rows, w_in, conv_w, m_bias_i, m_bias_f, m_norm_w, r_w0, r_wB, r_a0, r_aB, r_gB,
           r_kk, r_ka, r_bonus, r_norm_w, r_norm_b):
    p_ctx = h_ctx @ w_in
    p_lat = h_lat @ w_in
    p_ctx = jnp.concatenate([_conv_seq(p_ctx[..., :CONV_CH], conv_w[CONV_K // 2]), p_ctx[..., CONV_CH:]], -1)
    p_lat = jnp.concatenate([_conv_grid(p_lat[..., :CONV_CH], conv_w, rows), p_lat[..., CONV_CH:]], -1)
    u = jnp.concatenate([p_ctx, p_lat], axis=1)
    mq, mk, rr, rk, rv, mv, mo, gates, lw_f, lw_b, la, lg = jnp.split(u, SPLIT_POINTS, axis=-1)
    out_m = _mlstm_group(mq, mk, mv, mo, gates, m_bias_i, m_bias_f, m_norm_w)
    out_r = _rwkv7_group(rr, rk, rv, lw_f, lw_b, la, lg, r_w0, r_wB, r_a0, r_aB, r_gB, r_kk, r_ka, r_bonus,
                         r_norm_w, r_norm_b)
    return jnp.concatenate([out_m.astype(out_r.dtype), out_r], -1)


def _hier_moe(h, rt_g, rt_g_b, rt_e, rt_e_b, ex_gate, ex_up, ex_down):
    b, t, d = h.shape
    tok = h.reshape(b * t, d)
    n = tok.shape[0]
    lg = (tok @ rt_g + rt_g_b).astype(jnp.float32)
    p_grp = jax.nn.softmax(lg, axis=-1)
    grp = jnp.argmax(lg, axis=-1).astype(jnp.int32)
    p_top = jnp.take_along_axis(p_grp, grp[:, None], axis=-1)
    le = (tok @ rt_e + rt_e_b).astype(jnp.float32).reshape(n, N_GROUPS, E_PER_GROUP)
    le_grp = jnp.take_along_axis(le, jnp.broadcast_to(grp[:, None, None], (n, 1, E_PER_GROUP)), axis=1)[:, 0]
    top_val, top_idx = lax.top_k(le_grp, TOP_K_IN_GROUP)
    wts = jax.nn.softmax(top_val, axis=-1) * p_top
    e_flat = (grp[:, None] * E_PER_GROUP + top_idx.astype(jnp.int32)).reshape(-1)
    w_flat = wts.reshape(-1)
    t_flat = jnp.repeat(jnp.arange(n, dtype=jnp.int32), TOP_K_IN_GROUP)
    order = jnp.argsort(e_flat)
    e_s, t_s, w_s = e_flat[order], t_flat[order], w_flat[order]
    counts = jnp.zeros((N_EXPERTS,), jnp.int32).at[e_flat].add(1)
    starts = jnp.cumsum(counts) - counts
    padded = (counts + MOE_BLOCK - 1) // MOE_BLOCK * MOE_BLOCK
    pad_ends = jnp.cumsum(padded)
    pad_starts = pad_ends - padded
    dest = pad_starts[e_s] + jnp.arange(e_s.shape[0], dtype=jnp.int32) - starts[e_s]
    n_pairs = n * TOP_K_IN_GROUP
    buf = (-(-n_pairs // MOE_BLOCK) + N_EXPERTS) * MOE_BLOCK
    tok_buf = jnp.full((buf,), n, jnp.int32).at[dest].set(t_s)
    w_buf = jnp.zeros((buf,), w_s.dtype).at[dest].set(w_s)
    n_blk = buf // MOE_BLOCK
    blk_exp = jnp.minimum(jnp.searchsorted(pad_ends, jnp.arange(n_blk, dtype=jnp.int32) * MOE_BLOCK, side='right'),
                          N_EXPERTS - 1)
    tok_pad = jnp.concatenate([tok, jnp.zeros((1, d), tok.dtype)], 0)

    def expert_block(args):
        idx, w, e = args
        xb = tok_pad[idx]
        hb = jax.nn.silu(xb @ ex_gate[e]) * (xb @ ex_up[e])
        return (hb @ ex_down[e]) * w[:, None]

    y = lax.map(expert_block, (tok_buf.reshape(n_blk, MOE_BLOCK), w_buf.reshape(n_blk, MOE_BLOCK), blk_exp))
    out = jnp.zeros((n + 1, d), y.dtype).at[tok_buf].add(y.reshape(buf, d))
    return out[:n].reshape(b, t, d).astype(h.dtype)


def setup_inputs(seed: int = 0) -> dict:
    key = jax.random.key(seed)
    ks = jax.random.split(key, 40)
    def nrm(k, shape, s):
        return jax.random.normal(k, shape, jnp.float32) * s
    L = DEPTH
    return {
        'x': nrm(ks[0], (BATCH, SEQ, D_MODEL), 1.0),
        'c': nrm(ks[1], (BATCH, D_MODEL), 1.0),
        'ctx': nrm(ks[2], (BATCH, CTX_LEN, D_MODEL), 1.0),
        'c_ctx': nrm(ks[3], (D_MODEL,), 1.0),
        'w_ada': nrm(ks[4], (L, D_MODEL, 6 * D_MODEL), D_MODEL ** -0.5),
        'b_ada': nrm(ks[5], (L, 6 * D_MODEL), 0.02),
        'w_in': nrm(ks[6], (L, D_MODEL, IN_COLS), D_MODEL ** -0.5),
        'conv_w': nrm(ks[7], (L, CONV_K, CONV_K, CONV_CH), 0.3),
        'm_bias_i': nrm(ks[8], (L, 2, H_M), 0.5),
        'm_bias_f': 3.0 + nrm(ks[9], (L, 2, H_M), 0.5),
        'm_norm_w': 1.0 + nrm(ks[10], (L, W_M), 0.05),
        'r_w0': nrm(ks[11], (L, 2, W_R), 0.5),
        'r_wB': nrm(ks[12], (L, 2, W_LORA, W_R), W_LORA ** -0.5),
        'r_a0': nrm(ks[13], (L, W_R), 0.5),
        'r_aB': nrm(ks[14], (L, A_LORA, W_R), A_LORA ** -0.5),
        'r_gB': nrm(ks[15], (L, G_LORA, W_R), G_LORA ** -0.5),
        'r_kk': 0.85 + nrm(ks[16], (L, W_R), 0.05),
        'r_ka': 1.0 + nrm(ks[17], (L, W_R), 0.05),
        'r_bonus': nrm(ks[18], (L, H_R, D_HR), 0.1),
        'r_norm_w': 1.0 + nrm(ks[19], (L, W_R), 0.05),
        'r_norm_b': nrm(ks[20], (L, W_R), 0.02),
        'w_out': nrm(ks[21], (L, MIX_W, D_MODEL), BETA * MIX_W ** -0.5),
        'ln1_g': 1.0 + nrm(ks[22], (L, D_MODEL), 0.05),
        'ln1_b': nrm(ks[23], (L, D_MODEL), 0.02),
        'ln2_g': 1.0 + nrm(ks[24], (L, D_MODEL), 0.05),
        'ln2_b': nrm(ks[25], (L, D_MODEL), 0.02),
        'rt_g': nrm(ks[26], (L, D_MODEL, N_GROUPS), D_MODEL ** -0.5),
        'rt_g_b': nrm(ks[27], (L, N_GROUPS), 0.01),
        'rt_e': nrm(ks[28], (L, D_MODEL, N_EXPERTS), D_MODEL ** -0.5),
        'rt_e_b': nrm(ks[29], (L, N_EXPERTS), 0.01),
        'ex_gate': nrm(ks[30], (L, N_EXPERTS, D_MODEL, D_EXPERT), D_MODEL ** -0.5),
        'ex_up': nrm(ks[31], (L, N_EXPERTS, D_MODEL, D_EXPERT), D_MODEL ** -0.5),
        'ex_down': nrm(ks[32], (L, N_EXPERTS, D_EXPERT, D_MODEL), BETA * D_EXPERT ** -0.5),
    }


def reference(x, c, ctx, c_ctx, w_ada, b_ada, w_in, conv_w, m_bias_i, m_bias_f, m_norm_w, r_w0, r_wB, r_a0, r_aB,
              r_gB, r_kk, r_ka, r_bonus, r_norm_w, r_norm_b, w_out, ln1_g, ln1_b, ln2_g, ln2_b, rt_g, rt_g_b, rt_e,
              rt_e_b, ex_gate, ex_up, ex_down):
    rows = x.shape[1] // GRID_W
    for l in range(DEPTH):
        mod = jax.nn.silu(c) @ w_ada[l] + b_ada[l]
        mod_c = jax.nn.silu(c_ctx) @ w_ada[l] + b_ada[l]
        sh1, sc1, g1, sh2, sc2, g2 = jnp.split(mod[:, None, :], 6, axis=-1)
        sh1c, sc1c, g1c, sh2c, sc2c, g2c = jnp.split(mod_c, 6)
        mixed = _mixer(_modulate(ctx, sh1c, sc1c), _modulate(x, sh1, sc1), rows, w_in[l], conv_w[l], m_bias_i[l],
                       m_bias_f[l], m_norm_w[l], r_w0[l], r_wB[l], r_a0[l], r_aB[l], r_gB[l], r_kk[l], r_ka[l],
                       r_bonus[l], r_norm_w[l], r_norm_b[l])
        x = _layernorm(ALPHA * x + g1 * (mixed[:, CTX_LEN:] @ w_out[l]), ln1_g[l], ln1_b[l])
        ffn = _hier_moe(_modulate(x, sh2, sc2), rt_g[l], rt_g_b[l], rt_e[l], rt_e_b[l], ex_gate[l], ex_up[l], ex_down[l])
        x = _layernorm(ALPHA * x + g2 * ffn, ln2_g[l], ln2_b[l])
        if l + 1 < DEPTH:
            ctx = _layernorm(ALPHA * ctx + g1c * (mixed[:, :CTX_LEN] @ w_out[l]), ln1_g[l], ln1_b[l])
            ffn_c = _hier_moe(_modulate(ctx, sh2c, sc2c), rt_g[l], rt_g_b[l], rt_e[l], rt_e_b[l], ex_gate[l],
                              ex_up[l], ex_down[l])
            ctx = _layernorm(ALPHA * ctx + g2c * ffn_c, ln2_g[l], ln2_b[l])
    return x
```

```cpp
#ifndef HIP_EMU
#include <hip/hip_runtime.h>
#include <hip/hip_cooperative_groups.h>
#include <cstdio>
namespace cg = cooperative_groups;
#endif
#include <stdint.h>
#include <stddef.h>

#ifdef SMALL_CFG
constexpr int D_MODEL = 256, BATCH = 2, SEQ = 256, CTX_LEN = 128, H_M = 4, H_R = 4, N_GROUPS = 2, E_PER_GROUP = 4, D_EXPERT = 256;
#else
constexpr int D_MODEL = 1024, BATCH = 16, SEQ = 4096, CTX_LEN = 256, H_M = 8, H_R = 8, N_GROUPS = 4, E_PER_GROUP = 8, D_EXPERT = 512;
#endif
constexpr int GRID_W = 64, W_M = H_M * 64, W_R = H_R * 64, MIX_W = W_M + W_R, W_LORA = 64, A_LORA = 64, G_LORA = 128;
constexpr int CONV_CH = 2 * W_M + 3 * W_R;
constexpr int OFF_MQ = 0, OFF_MK = W_M, OFF_RR = 2 * W_M, OFF_RK = 2 * W_M + W_R, OFF_RV = 2 * W_M + 2 * W_R, OFF_MV = CONV_CH,
              OFF_MO = OFF_MV + W_M, OFF_GATES = OFF_MO + W_M, OFF_LWF = OFF_GATES + 4 * H_M, OFF_LWB = OFF_LWF + W_LORA,
              OFF_LA = OFF_LWB + W_LORA, OFF_LG = OFF_LA + A_LORA, IN_COLS = OFF_LG + G_LORA;
constexpr int IN_PAD = (IN_COLS + 255) / 256 * 256;
constexpr int P2_COLS = IN_COLS - CONV_CH, P2_LD = (P2_COLS + 63) / 64 * 64;
constexpr int T_MV = OFF_MV - CONV_CH, T_MO = OFF_MO - CONV_CH, T_GATES = OFF_GATES - CONV_CH, T_LWF = OFF_LWF - CONV_CH, T_LWB = OFF_LWB - CONV_CH, T_LA = OFF_LA - CONV_CH, T_LG = OFF_LG - CONV_CH;
static_assert(CONV_CH % 256 == 0 && T_MV == 0 && T_MO == W_M, "split-P layout");
constexpr int T_ALL = CTX_LEN + SEQ, NTOK = BATCH * T_ALL, NLAT = BATCH * SEQ, GRID_ROWS = SEQ / GRID_W;
constexpr int NC_CTX = CTX_LEN / 64, NC_ALL = T_ALL / 64;
__host__ __device__ __forceinline__ size_t pc_off(int col, int tok) { return ((size_t)(col >> 6) * NTOK + tok) * 64 + (col & 63); }
constexpr int N_EXPERTS = N_GROUPS * E_PER_GROUP, MOE_BLOCK = 256, N_PAIRS = 2 * NLAT, MAX_RB = N_PAIRS / MOE_BLOCK + N_EXPERTS,
              ROWS_P = MAX_RB * MOE_BLOCK;
constexpr int MAX_GRID = 1024;
constexpr float ALPHA = 1.189207115002721f, DECAY_SCALE = 0.6065306597126334f, LN_EPS = 1e-6f, GN_EPS = 64e-5f;
constexpr int NTHREADS = 512, NWAVES = 8;
constexpr int REP_RWKV = 1, REP_MLSTM = 1, REP_GEMM = 1, REP_PRO = 1, REP_LNMOD = 1, REP_COMB = 1, REP_LN1 = 1, REP_ROUTE = 1, REP_CONV = 1, REP_RWSCAN = 1, REP_SYNC = 1, REP_FINAL = 1, REP_RW_S3 = 1, REP_RW_ST3 = 1, REP_RW_S1 = 1, REP_RW_MM = 1, REP_RW_S2 = 1, REP_RW_ST2 = 1, REP_G1 = 1, REP_G2 = 1, REP_G3 = 1, REP_G4 = 1, REP_G5 = 1;
constexpr int LDS_BYTES = 144 * 1024;
static_assert(N_EXPERTS <= 32 && N_GROUPS <= 4 && D_MODEL % 256 == 0 && IN_COLS % 8 == 0 && SEQ % 256 == 0, "shape assumptions");

typedef unsigned short bf16_t;
typedef short bf16x8 __attribute__((ext_vector_type(8)));
typedef float f32x4 __attribute__((ext_vector_type(4)));
typedef unsigned u32x4 __attribute__((ext_vector_type(4)));
typedef unsigned u32x2 __attribute__((ext_vector_type(2)));

#ifdef HIP_EMU
#define LAS
#define MFMA16(a, b, c) emu_mfma_16x16x32_bf16(a, b, c)
#define DYN_SMEM(name) unsigned char* name = emu_cur->blk->smem
#define GLDS16(g, l) emu_glds16((const void*)(g), (void*)(l))
#define S_BARRIER() __syncthreads()
#define WAIT_V(n)
#define WAIT_V_EPI(nst)
#define WAIT_L(n)
#define SETPRIO(x)
#define SCHED_BAR()
#define RFL(x) (x)
#define GRID_SYNC() emu_grid_sync()
#define GRID_SYNC_CG() emu_grid_sync()
#define LDS_BAR() __syncthreads()
#define WAVE_SYNC() emu_wave_sync()
#define OPAQUE_S(x)
#define OPAQUE(x)
#define BALLOT(p) emu_ballot(p)
#define POPCLL(x) __builtin_popcountll(x)
#define DPP_XOR1(v) emu_dpp_quad(v, 1, 0, 3, 2)
#define DPP_XOR2(v) emu_dpp_quad(v, 2, 3, 0, 1)
#define DPP_HMIRROR(v) emu_dpp_half_mirror(v)
#define DPP_QBCAST(v, j) emu_dpp_quad(v, j, j, j, j)
#else
#define LAS __attribute__((address_space(3)))
#define MFMA16(a, b, c) __builtin_amdgcn_mfma_f32_16x16x32_bf16(a, b, c, 0, 0, 0)
#define DYN_SMEM(name) extern __shared__ __attribute__((aligned(16))) unsigned char name[]
#define GLDS16(g, l) __builtin_amdgcn_global_load_lds((const unsigned*)(g), (LAS unsigned*)(l), 16, 0, 0)
#define S_BARRIER() __builtin_amdgcn_s_barrier()
#define WAIT_V(n) asm volatile("s_waitcnt vmcnt(" #n ")" ::: "memory")
#define WAIT_V_EPI(nst) do { if ((nst) == 16) asm volatile("s_waitcnt vmcnt(24)" ::: "memory"); else if ((nst) == 32) asm volatile("s_waitcnt vmcnt(40)" ::: "memory"); else asm volatile("s_waitcnt vmcnt(6)" ::: "memory"); } while (0)
#define WAIT_L(n) asm volatile("s_waitcnt lgkmcnt(" #n ")" ::: "memory")
#define SETPRIO(x) __builtin_amdgcn_s_setprio(x)
#define SCHED_BAR() __builtin_amdgcn_sched_barrier(0)
#define RFL(x) __builtin_amdgcn_readfirstlane(x)
#define GRID_SYNC_CG() cg::this_grid().sync()
#define LDS_BAR() do { asm volatile("s_waitcnt lgkmcnt(0)" ::: "memory"); __builtin_amdgcn_s_barrier(); asm volatile("" ::: "memory"); } while (0)
#define GRID_SYNC() do { for (int _r = 0; _r < REP_SYNC; ++_r) xcd_barrier(gbar); } while (0)
#define WAVE_SYNC() __builtin_amdgcn_wave_barrier()
#define OPAQUE(x) asm volatile("" : "+v"(x))
#define OPAQUE_S(x) asm volatile("" : "+s"(x))
#define BALLOT(p) __ballot(p)
#define POPCLL(x) __popcll(x)
#define DPP_F(v, ctrl) __builtin_bit_cast(float, __builtin_amdgcn_update_dpp(0, __builtin_bit_cast(int, (float)(v)), ctrl, 0xF, 0xF, true))
#define DPP_XOR1(v) DPP_F(v, 0xB1)
#define DPP_XOR2(v) DPP_F(v, 0x4E)
#define DPP_HMIRROR(v) DPP_F(v, 0x141)
#define DPP_QBCAST(v, j) DPP_F(v, (j) * 0x55)
#endif

__device__ __forceinline__ float bf2f(bf16_t h) { return __builtin_bit_cast(float, (unsigned)h << 16); }
__device__ __forceinline__ bf16_t f2bf(float f) { unsigned u = __builtin_bit_cast(unsigned, f); u += 0x7fffu + ((u >> 16) & 1u); return (bf16_t)(u >> 16); }
__device__ __forceinline__ unsigned pack_bf16(float lo, float hi) {
#ifdef HIP_EMU
    return (unsigned)f2bf(lo) | ((unsigned)f2bf(hi) << 16);
#else
    typedef float f32x2_t __attribute__((ext_vector_type(2))); typedef __bf16 bf16x2_t __attribute__((ext_vector_type(2)));
    const f32x2_t f = {lo, hi}; const bf16x2_t h = __builtin_convertvector(f, bf16x2_t); return __builtin_bit_cast(unsigned, h);
#endif
}
#ifdef HIP_EMU
__device__ __forceinline__ float fexp(float x) { return expf(x); }
__device__ __forceinline__ float frcp(float x) { return 1.0f / x; }
__device__ __forceinline__ float frsq(float x) { return 1.0f / sqrtf(x); }
__device__ __forceinline__ float flog(float x) { return logf(x); }
#else
__device__ __forceinline__ float fexp(float x) { return __expf(x); }
__device__ __forceinline__ float frcp(float x) { return __builtin_amdgcn_rcpf(x); }
__device__ __forceinline__ float frsq(float x) { return __builtin_amdgcn_rsqf(x); }
__device__ __forceinline__ float flog(float x) { return __logf(x); }
#endif
#ifdef HIP_EMU
__device__ __forceinline__ float fma_(float a, float b, float c) { return a * b + c; }
__device__ __forceinline__ float mul_(float a, float b) { return a * b; }
__device__ __forceinline__ float add_(float a, float b) { return a + b; }
#else
__device__ __forceinline__ float fma_(float a, float b, float c) { float d; asm("v_fma_f32 %0, %1, %2, %3" : "=v"(d) : "v"(a), "v"(b), "v"(c)); return d; }
__device__ __forceinline__ float mul_(float a, float b) { float d; asm("v_mul_f32 %0, %1, %2" : "=v"(d) : "v"(a), "v"(b)); return d; }
__device__ __forceinline__ float add_(float a, float b) { float d; asm("v_add_f32 %0, %1, %2" : "=v"(d) : "v"(a), "v"(b)); return d; }
#endif
__device__ __forceinline__ float sigmoidf_(float x) { return frcp(1.0f + fexp(-x)); }
__device__ __forceinline__ float siluf_(float x) { return x * frcp(1.0f + fexp(-x)); }
__device__ __forceinline__ float ftanh(float x) { return 1.0f - 2.0f * frcp(fexp(2.0f * x) + 1.0f); }
__device__ __forceinline__ float logsigmoidf_(float x) { return fminf(x, 0.0f) - flog(1.0f + fexp(-fabsf(x))); }
__device__ __forceinline__ void split8(const float (&x)[8], bf16x8& hi, bf16x8& lo) {
    u32x4 h, l;
#pragma unroll
    for (int i = 0; i < 4; ++i) { const unsigned hp = pack_bf16(x[2 * i], x[2 * i + 1]);
        const float f0 = __builtin_bit_cast(float, hp << 16), f1 = __builtin_bit_cast(float, hp & 0xffff0000u);
        h[i] = hp; l[i] = pack_bf16(x[2 * i] - f0, x[2 * i + 1] - f1); }
    hi = __builtin_bit_cast(bf16x8, h); lo = __builtin_bit_cast(bf16x8, l);
}
__device__ __forceinline__ float red8(float v) { v += DPP_XOR1(v); v += DPP_XOR2(v); v += DPP_HMIRROR(v); return v; }

#ifdef HIP_EMU
__device__ __forceinline__ float wave_scan_add(float v) { const int l = emu_cur->lane; auto t = emu_wave_gather(&v, 1); float s = 0.f; for (int i = 0; i <= l; ++i) { float x; memcpy(&x, &t[i][0], 4); s += x; } return s; }
__device__ __forceinline__ float wave_scan_max(float v) { const int l = emu_cur->lane; auto t = emu_wave_gather(&v, 1); float s = -INFINITY; for (int i = 0; i <= l; ++i) { float x; memcpy(&x, &t[i][0], 4); s = fmaxf(s, x); } return s; }
#else
#define DPP_UPD(oldv, v, ctrl, rmask) __builtin_bit_cast(float, __builtin_amdgcn_update_dpp(__builtin_bit_cast(int, (float)(oldv)), __builtin_bit_cast(int, (float)(v)), ctrl, rmask, 0xF, false))
__device__ __forceinline__ float wave_scan_add(float v) {
    v += DPP_UPD(0.f, v, 0x111, 0xF); v += DPP_UPD(0.f, v, 0x112, 0xF); v += DPP_UPD(0.f, v, 0x114, 0xF); v += DPP_UPD(0.f, v, 0x118, 0xF);
    v += DPP_UPD(0.f, v, 0x142, 0xA); v += DPP_UPD(0.f, v, 0x143, 0xC); return v;
}
__device__ __forceinline__ float wave_scan_max(float v) {
    const float ninf = -__builtin_inff();
    v = fmaxf(v, DPP_UPD(ninf, v, 0x111, 0xF)); v = fmaxf(v, DPP_UPD(ninf, v, 0x112, 0xF)); v = fmaxf(v, DPP_UPD(ninf, v, 0x114, 0xF)); v = fmaxf(v, DPP_UPD(ninf, v, 0x118, 0xF));
    v = fmaxf(v, DPP_UPD(ninf, v, 0x142, 0xA)); v = fmaxf(v, DPP_UPD(ninf, v, 0x143, 0xC)); return v;
}
#endif
__device__ __forceinline__ float wave_sum(float v) {
    v += __shfl_xor(v, 32); v += __shfl_xor(v, 16); v += __shfl_xor(v, 8); v += __shfl_xor(v, 4); v += __shfl_xor(v, 2); v += __shfl_xor(v, 1); return v;
}

#ifdef SMALL_CFG
constexpr bool WS_OVERLAY = false;
#else
constexpr bool WS_OVERLAY = true;
#endif
constexpr size_t al256(size_t x) { return (x + 255) / 256 * 256; }
constexpr size_t cmax(size_t a, size_t b) { return a > b ? a : b; }
constexpr size_t SZ_PC = al256((size_t)NTOK * CONV_CH * 2), SZ_PT = al256((size_t)NTOK * P2_LD * 2), SZ_P = SZ_PC + SZ_PT;
constexpr size_t SZ_H = al256((size_t)NTOK * D_MODEL * 2);
constexpr size_t SZ_U = al256((size_t)NTOK * CONV_CH * 2);
constexpr size_t SZ_O = al256((size_t)NLAT * D_MODEL * 4);
constexpr size_t SZ_HID = al256((size_t)ROWS_P * D_EXPERT * 2);
constexpr size_t SZ_XM = al256((size_t)(NLAT + 1) * D_MODEL * 2);
constexpr size_t SZ_YPAIR = al256((size_t)ROWS_P * D_MODEL * 2);
constexpr size_t WS_P = 0, WS_PC = 0, WS_PT = WS_PC + SZ_PC;
constexpr size_t WS_R2 = WS_P + SZ_P;
constexpr size_t SZ_R2 = WS_OVERLAY ? cmax(cmax(SZ_H, SZ_U), cmax(SZ_O, SZ_HID)) : SZ_H + SZ_U + SZ_O + SZ_HID;
constexpr size_t WS_H = WS_R2;
constexpr size_t WS_U = WS_OVERLAY ? WS_R2 : WS_H + SZ_H;
constexpr size_t WS_O = WS_OVERLAY ? WS_R2 : WS_U + SZ_U;
constexpr size_t WS_X1 = WS_O;
constexpr size_t SZ_OB = al256((size_t)NLAT * D_MODEL * 2);
constexpr size_t WS_HID = WS_OVERLAY ? WS_P + SZ_YPAIR : WS_O + SZ_O;
constexpr size_t WS_WGU = WS_R2 + SZ_R2;
constexpr size_t WS_WDN = WS_WGU + al256((size_t)N_EXPERTS * 2 * D_EXPERT * D_MODEL * 2);
constexpr size_t WS_WIN = WS_WDN + al256((size_t)N_EXPERTS * D_MODEL * D_EXPERT * 2);
constexpr size_t WS_WOUT = WS_WIN + al256((size_t)IN_PAD * D_MODEL * 2);
constexpr int GK = 256;
static_assert(IN_COLS - OFF_LWB == GK && W_R % 256 == 0, "g GEMM layout");
constexpr size_t WS_GBT = WS_WOUT + al256((size_t)D_MODEL * MIX_W * 2);
constexpr size_t WS_MOD = WS_GBT + al256((size_t)W_R * GK * 2);
constexpr size_t WS_EIDX = WS_MOD + al256((size_t)(BATCH + 1) * 6 * D_MODEL * 4);
constexpr size_t WS_EWT = WS_EIDX + al256((size_t)N_PAIRS * 4);
constexpr size_t WS_DEST = WS_EWT + al256((size_t)N_PAIRS * 4);
constexpr size_t WS_CCNT = WS_DEST + al256((size_t)N_PAIRS * 4);
constexpr size_t WS_TOKBUF = WS_CCNT + al256((size_t)MAX_GRID * N_EXPERTS * 4);
constexpr size_t WS_WBUF = WS_TOKBUF + al256((size_t)ROWS_P * 4);
constexpr size_t WS_BLKEXP = WS_WBUF + al256((size_t)ROWS_P * 4);
constexpr size_t WS_BAR = WS_BLKEXP + al256((size_t)(MAX_RB + 64) * 4);
constexpr size_t WS_END = WS_BAR + al256((size_t)3456 * 4);
constexpr size_t WS_XM = WS_OVERLAY ? WS_R2 + SZ_OB : WS_END;
constexpr size_t WS_YPAIR = WS_OVERLAY ? WS_P : WS_XM + SZ_XM;
constexpr size_t WS_TOTAL = WS_OVERLAY ? WS_END : WS_YPAIR + SZ_YPAIR;
static_assert(!WS_OVERLAY || (SZ_YPAIR + SZ_HID <= SZ_P && SZ_OB + SZ_XM <= SZ_R2), "xm / ypair / hidden overlays");
static_assert(WS_TOTAL <= ((size_t)1 << 30), "workspace > 1 GiB");

namespace pg8 {
constexpr int BM = 256, BK = 64, HALF = 128, HTB = HALF * BK * 2, STAGE_BYTES = 8 * HTB, NXCD = 8, WGM = 16;
__host__ __device__ __forceinline__ int lds_byte(int r, int c) { const int st = (r >> 4) * 2 + (c >> 5), rr = r & 15, cc = c & 31, ob = rr * 64 + cc * 2; return st * 1024 + (ob ^ (((ob >> 9) & 1) << 5)); }
__host__ __device__ __forceinline__ void stage_rc(int b, int& R, int& C) { const int st = b / 1024, sb = b % 1024, swz = sb ^ (((sb >> 9) & 1) << 5); R = (st >> 1) * 16 + swz / 64; C = (st & 1) * 32 + (swz % 64) / 2; }
__host__ __device__ __forceinline__ int perm32(int rho) { const int n = rho >> 4, i = rho & 15; return 8 * (i >> 2) + 4 * n + (i & 3); }
struct Unit { int pm, pn; };
struct Gemm { const bf16_t* A; const bf16_t* Bt; int K; int lda; const int* a_rows; const int* blk_exp; size_t b_stride; int seg_tiles, seg_stride, seg_off; };
__device__ __forceinline__ int tile_row0(const Gemm& g, int pm) { return g.seg_tiles ? (pm / g.seg_tiles) * g.seg_stride + g.seg_off + (pm % g.seg_tiles) * BM : pm * BM; }
struct StaticOrder {
    int nM, nN, nwg, G, c;
    __host__ __device__ void init(int M, int N, int G_, int c_) { nM = M / BM; nN = N / BM; nwg = nM * nN; G = G_; c = c_; }
    __host__ __device__ bool next(int i, Unit& u) const {
        const long L = (long)i * G + c; if (L >= nwg) return false;
        int wgid = (int)L; { const int q = nwg / NXCD, r = nwg % NXCD, xcd = wgid % NXCD, off = wgid / NXCD; wgid = (xcd < r ? xcd * (q + 1) : r * (q + 1) + (xcd - r) * q) + off; }
        const int nig = WGM * nN, gid = wgid / nig, fm = gid * WGM, gsz = (nM - fm) < WGM ? (nM - fm) : WGM;
        u.pm = fm + ((wgid % nig) % gsz); u.pn = (wgid % nig) / gsz; return true;
    }
};
struct OwnTile {
    int first, step, nT, nN;
    __host__ __device__ bool next(int i, Unit& u) const { const int t = first + (i / nN) * step; if (t >= nT) return false; u.pm = t; u.pn = i % nN; return true; }
};
struct EpiF32 {
    static constexpr bool PERM = false, MAPPED = false; static constexpr int NST = 32; float* C; int ldc;
    __device__ __forceinline__ bool full(const Unit&) const { return true; }
    __device__ __forceinline__ void operator()(const f32x4 (&acc)[2][2][4][2], const Unit& u, int r0, int wr, int wc, int fr, int fq) const {
        const int row0 = r0 + wr * 64 + fr, col0 = u.pn * BM + wc * 32 + 4 * fq;
#pragma unroll
        for (int ai = 0; ai < 2; ++ai)
#pragma unroll
            for (int m = 0; m < 4; ++m) { float* rowp = C + (size_t)(row0 + ai * HALF + m * 16) * ldc + col0;
#pragma unroll
                for (int bj = 0; bj < 2; ++bj)
#pragma unroll
                    for (int n = 0; n < 2; ++n) *(f32x4*)(rowp + bj * HALF + n * 16) = acc[ai][bj][m][n]; }
    }
};
struct EpiBf16 {
    static constexpr bool PERM = true, MAPPED = false; static constexpr int NST = 16; bf16_t* O; int ldc; int n_valid; const float* row_scale;
    __device__ __forceinline__ bool full(const Unit& u) const { return (u.pn + 1) * BM <= n_valid; }
    __device__ __forceinline__ void operator()(const f32x4 (&acc)[2][2][4][2], const Unit& u, int r0, int wr, int wc, int fr, int fq) const {
        const int row0 = r0 + wr * 64 + fr, col0 = u.pn * BM + wc * 32 + 8 * fq;
#pragma unroll
        for (int ai = 0; ai < 2; ++ai)
#pragma unroll
            for (int m = 0; m < 4; ++m) { const int row = row0 + ai * HALF + m * 16; bf16_t* rowp = O + (size_t)row * ldc + col0; const float sc = row_scale ? row_scale[row] : 1.0f;
#pragma unroll
                for (int bj = 0; bj < 2; ++bj) { const f32x4 v0 = acc[ai][bj][m][0] * sc, v1 = acc[ai][bj][m][1] * sc;
                    u32x4 w; w.x = pack_bf16(v0[0], v0[1]); w.y = pack_bf16(v0[2], v0[3]); w.z = pack_bf16(v1[0], v1[1]); w.w = pack_bf16(v1[2], v1[3]);
                    if (col0 + bj * HALF < n_valid) *(u32x4*)(rowp + bj * HALF) = w; } }
    }
};
struct EpiInProj {
    static constexpr bool PERM = true, MAPPED = false; static constexpr int NST = 16; bf16_t* Pc; bf16_t* Pt;
    __device__ __forceinline__ bool full(const Unit& u) const { return (u.pn + 1) * BM <= IN_COLS; }
    __device__ __forceinline__ void operator()(const f32x4 (&acc)[2][2][4][2], const Unit& u, int r0, int wr, int wc, int fr, int fq) const {
        static_assert(CONV_CH % BM == 0, "a column tile must not straddle the slab-major / token-major seam");
        const int row0 = r0 + wr * 64 + fr, col0 = u.pn * BM + wc * 32 + 8 * fq;
        const bool conv = (u.pn + 1) * BM <= CONV_CH;
        bf16_t* base0; bf16_t* base1; size_t rstride;
        if (conv) { base0 = Pc + pc_off(col0, row0); base1 = Pc + pc_off(col0 + HALF, row0); rstride = 64; }
        else { base0 = Pt + (size_t)row0 * P2_LD + (col0 - CONV_CH); base1 = base0 + HALF; rstride = P2_LD; }
        const bool ok0 = col0 < IN_COLS, ok1 = col0 + HALF < IN_COLS;
#pragma unroll
        for (int ai = 0; ai < 2; ++ai)
#pragma unroll
            for (int m = 0; m < 4; ++m) { const size_t ro = (size_t)(ai * HALF + m * 16) * rstride;
#pragma unroll
                for (int bj = 0; bj < 2; ++bj) { const f32x4 v0 = acc[ai][bj][m][0], v1 = acc[ai][bj][m][1];
                    u32x4 w; w.x = pack_bf16(v0[0], v0[1]); w.y = pack_bf16(v0[2], v0[3]); w.z = pack_bf16(v1[0], v1[1]); w.w = pack_bf16(v1[2], v1[3]);
                    if (bj ? ok1 : ok0) *(u32x4*)((bj ? base1 : base0) + ro) = w; } }
    }
};
struct EpiBf16Mapped : EpiBf16 { static constexpr bool MAPPED = true; };
struct EpiSwiGLU {
    static constexpr bool PERM = false, MAPPED = false; static constexpr int NST = 16; bf16_t* H; int ldh;
    __device__ __forceinline__ bool full(const Unit&) const { return true; }
    __device__ __forceinline__ void operator()(const f32x4 (&acc)[2][2][4][2], const Unit& u, int r0, int wr, int wc, int fr, int fq) const {
        const int row0 = r0 + wr * 64 + fr, col0 = u.pn * (BM / 2) + wc * 16 + 4 * fq;
#pragma unroll
        for (int ai = 0; ai < 2; ++ai)
#pragma unroll
            for (int m = 0; m < 4; ++m) { bf16_t* rowp = H + (size_t)(row0 + ai * HALF + m * 16) * ldh + col0;
#pragma unroll
                for (int bj = 0; bj < 2; ++bj) { const f32x4 gv = acc[ai][bj][m][0], uv = acc[ai][bj][m][1];
                    u32x2 w; w.x = pack_bf16(siluf_(gv[0]) * uv[0], siluf_(gv[1]) * uv[1]); w.y = pack_bf16(siluf_(gv[2]) * uv[2], siluf_(gv[3]) * uv[3]);
                    *(u32x2*)(rowp + bj * (HALF / 2)) = w; } }
    }
};

template <class Epi, class Sched, bool GATHER>
__device__ __forceinline__ void gemm_phase(LAS unsigned char* lds, const Gemm g, const Sched& S, const Epi& E) {
    int tid = threadIdx.x; OPAQUE(tid);
    const int wid = RFL(tid >> 6), lane = tid & 63, wr = wid >> 2, wc = wid & 3, fr = lane & 15, fq = lane >> 4;
    const int K = g.K, nt = K / BK;
    int sR[2], sC[2];
    unsigned voffA[2], voffB[2];
#pragma unroll
    for (int i = 0; i < 2; ++i) { int R, C; stage_rc(tid * 16 + i * 8192, R, C); sR[i] = R; sC[i] = C; const int Rb = Epi::PERM ? ((R & ~31) + perm32(R & 31)) : R;
        voffA[i] = (unsigned)(R * g.lda + C) * 2u; voffB[i] = (unsigned)(Rb * K + C) * 2u; }
    const size_t kstep = (size_t)(BK * 2);
    const size_t hstep = (size_t)HALF * K * 2, hstepA = (size_t)HALF * g.lda * 2;
    const size_t tstep = 2 * hstep;
    const unsigned ldsw = (unsigned)wid * 1024u;
    const int aoff = lds_byte(wr * 64 + fr, fq * 8), boff = lds_byte(wc * 32 + fr, fq * 8);
#define PG8_SA(b, h) (((b) * 2 + (h)) * HTB)
#define PG8_SB(b, h) ((4 + (b) * 2 + (h)) * HTB)
#define PG8_STAGE(bufoff, gbase, voff) do { _Pragma("unroll") for (int _i = 0; _i < 2; ++_i) \
        GLDS16((const char*)(gbase) + (voff)[_i], lds + (bufoff) + ldsw + _i * 8192); } while (0)
#define PG8_STAGE_A(b, h, kofs, usenext) do { if constexpr (GATHER) { PG8_STAGE(PG8_SA(b, h), (const char*)g.A + (kofs), (usenext) ? vAn[h] : vAc[h]); } \
        else { PG8_STAGE(PG8_SA(b, h), ((usenext) ? nA : cA) + (size_t)(h) * hstepA + (kofs), voffA); } } while (0)
#define PG8_LDA(dst, b, h) do { _Pragma("unroll") for (int m = 0; m < 4; ++m) _Pragma("unroll") for (int k = 0; k < 2; ++k) dst[m][k] = *(const LAS bf16x8*)(lds + PG8_SA(b, h) + aoff + m * 2048 + k * 1024); } while (0)
#define PG8_LDB(dst, b, h) do { _Pragma("unroll") for (int n = 0; n < 2; ++n) _Pragma("unroll") for (int k = 0; k < 2; ++k) dst[n][k] = *(const LAS bf16x8*)(lds + PG8_SB(b, h) + boff + n * 2048 + k * 1024); } while (0)
#define PG8_MMA(ai, bj, At, Bt) do { SETPRIO(1); _Pragma("unroll") for (int m = 0; m < 4; ++m) _Pragma("unroll") for (int n = 0; n < 2; ++n) _Pragma("unroll") for (int k = 0; k < 2; ++k) \
        acc[ai][bj][m][n] = MFMA16(Bt[n][k], At[m][k], acc[ai][bj][m][n]); SETPRIO(0); } while (0)
#define PG8_GATHER_OFFS(u, v) do { _Pragma("unroll") for (int _h = 0; _h < 2; ++_h) _Pragma("unroll") for (int _i = 0; _i < 2; ++_i) { \
        const int _row = g.a_rows[(u).pm * BM + _h * HALF + sR[_i]]; v[_h][_i] = (unsigned)(_row * g.lda + sC[_i]) * 2u; } } while (0)
    Unit cur, nxt; int ui = 0;
    if (!S.next(0, cur)) return;
    f32x4 acc[2][2][4][2];
#pragma unroll
    for (int a = 0; a < 2; ++a)
#pragma unroll
        for (int b = 0; b < 2; ++b)
#pragma unroll
            for (int m = 0; m < 4; ++m)
#pragma unroll
                for (int n = 0; n < 2; ++n) acc[a][b][m][n] = (f32x4){0.f, 0.f, 0.f, 0.f};
    bf16x8 At[4][2], B0[2][2], B1[2][2];
    unsigned vAc[2][2], vAn[2][2];
    if constexpr (GATHER) { PG8_GATHER_OFFS(cur, vAc); }
    else {
#pragma unroll
        for (int h = 0; h < 2; ++h)
#pragma unroll
            for (int i = 0; i < 2; ++i) { vAc[h][i] = 0u; vAn[h][i] = 0u; }
    }
    int cr0 = tile_row0(g, cur.pm);
    const char* cA = (const char*)g.A + (GATHER ? (size_t)0 : (size_t)cr0 * g.lda * 2);
    const char* cB = (const char*)g.Bt + (g.blk_exp ? (size_t)g.blk_exp[cur.pm] * g.b_stride * 2 : (size_t)0) + (size_t)cur.pn * tstep;
    const char* nA = cA;
    PG8_STAGE(PG8_SB(0, 0), cB, voffB); PG8_STAGE_A(0, 0, (size_t)0, false); PG8_STAGE(PG8_SB(0, 1), cB + hstep, voffB); PG8_STAGE_A(0, 1, (size_t)0, false);
    if (wr == 1) S_BARRIER();
    WAIT_V(4); S_BARRIER();
    PG8_STAGE(PG8_SB(1, 0), cB + kstep, voffB); PG8_STAGE_A(1, 0, kstep, false); PG8_STAGE(PG8_SB(1, 1), cB + hstep + kstep, voffB);
    WAIT_V(6); S_BARRIER();
    bool relax = false;
    for (;;) {
        const bool has_next = S.next(ui + 1, nxt);
        const int nr0 = has_next ? tile_row0(g, nxt.pm) : cr0;
        nA = (has_next && !GATHER) ? (const char*)g.A + (size_t)nr0 * g.lda * 2 : cA;
        const char* nB = has_next ? (const char*)g.Bt + (g.blk_exp ? (size_t)g.blk_exp[nxt.pm] * g.b_stride * 2 : (size_t)0) + (size_t)nxt.pn * tstep : cB;
        if constexpr (GATHER) {
            if (has_next) { PG8_GATHER_OFFS(nxt, vAn); }
            else {
#pragma unroll
                for (int h = 0; h < 2; ++h)
#pragma unroll
                    for (int i = 0; i < 2; ++i) vAn[h][i] = vAc[h][i];
            }
        }
        for (int t = 0; t < nt; t += 2) {
            const bool last = (t == nt - 2);
            const size_t k1 = (size_t)(t + 1) * kstep;
            const size_t k2 = last ? (size_t)0 : (size_t)(t + 2) * kstep, k3 = k2 + kstep;
            const char* b2 = last ? nB : cB + (size_t)(t + 2) * kstep; const char* b3 = b2 + kstep;
            PG8_LDB(B0, 0, 0); SCHED_BAR(); PG8_LDA(At, 0, 0); PG8_STAGE_A(1, 1, k1, false);
            WAIT_L(8); S_BARRIER(); WAIT_L(0); PG8_MMA(0, 0, At, B0); S_BARRIER(); SCHED_BAR();
            PG8_LDB(B1, 0, 1); PG8_STAGE(PG8_SB(0, 0), b2, voffB);
            S_BARRIER(); WAIT_L(0); PG8_MMA(0, 1, At, B1); S_BARRIER();
            PG8_LDA(At, 0, 1); PG8_STAGE_A(0, 0, k2, last);
            S_BARRIER(); WAIT_L(0); PG8_MMA(1, 0, At, B0); S_BARRIER(); SCHED_BAR();
            PG8_STAGE(PG8_SB(0, 1), b2 + hstep, voffB);
            if (!GATHER && t == 0 && relax) { WAIT_V_EPI(Epi::NST); } else { WAIT_V(6); }
            S_BARRIER(); PG8_MMA(1, 1, At, B1); S_BARRIER();
            PG8_LDB(B0, 1, 0); SCHED_BAR(); PG8_LDA(At, 1, 0); PG8_STAGE_A(0, 1, k2, last);
            WAIT_L(8); S_BARRIER(); WAIT_L(0); PG8_MMA(0, 0, At, B0); S_BARRIER(); SCHED_BAR();
            PG8_LDB(B1, 1, 1); PG8_STAGE(PG8_SB(1, 0), b3, voffB);
            if (!GATHER && t == 0 && relax) WAIT_V(10);
            S_BARRIER(); WAIT_L(0); PG8_MMA(0, 1, At, B1); S_BARRIER();
            PG8_LDA(At, 1, 1); PG8_STAGE_A(1, 0, k3, last);
            S_BARRIER(); WAIT_L(0); PG8_MMA(1, 0, At, B0); S_BARRIER(); SCHED_BAR();
            PG8_STAGE(PG8_SB(1, 1), b3 + hstep, voffB);
            WAIT_V(6);
            S_BARRIER(); PG8_MMA(1, 1, At, B1); S_BARRIER();
        }
        E(acc, cur, Epi::MAPPED ? cr0 : cur.pm * BM, wr, wc, fr, fq);
        if (!has_next) break;
        if constexpr (!GATHER) relax = E.full(cur);
#pragma unroll
        for (int a = 0; a < 2; ++a)
#pragma unroll
            for (int b = 0; b < 2; ++b)
#pragma unroll
                for (int m = 0; m < 4; ++m)
#pragma unroll
                    for (int n = 0; n < 2; ++n) acc[a][b][m][n] = (f32x4){0.f, 0.f, 0.f, 0.f};
        cur = nxt; cA = nA; cB = nB; cr0 = nr0; ++ui;
        if constexpr (GATHER) {
#pragma unroll
            for (int h = 0; h < 2; ++h)
#pragma unroll
                for (int i = 0; i < 2; ++i) vAc[h][i] = vAn[h][i];
        }
    }
    WAIT_V(0);
    if (wr == 0) S_BARRIER();
    S_BARRIER();
#undef PG8_SA
#undef PG8_SB
#undef PG8_STAGE
#undef PG8_STAGE_A
#undef PG8_LDA
#undef PG8_LDB
#undef PG8_MMA
#undef PG8_GATHER_OFFS
}
}


#ifndef HIP_EMU
#define XB_TMO      128
#define XB_XCNT(j)  (256  + 64 * (j))
#define XB_XSUB(j)  (1280 + 64 * (j))
#define XB_XGEN(j)  (2304 + 64 * (j))
#define XB_TOP      3328
#define XB_TOPGEN   3392
#define XCD_BAR_WORDS 3456
#define XB_SPIN_CAP (1u << 22)
__device__ __forceinline__ unsigned xb_ld(unsigned* p)              { return __hip_atomic_load(p, __ATOMIC_RELAXED, __HIP_MEMORY_SCOPE_AGENT); }
__device__ __forceinline__ unsigned xb_add(unsigned* p, unsigned v) { return __hip_atomic_fetch_add(p, v, __ATOMIC_RELAXED, __HIP_MEMORY_SCOPE_AGENT); }
__device__ __forceinline__ unsigned xb_xcc_id() { return (unsigned)__builtin_amdgcn_s_getreg((3 << 11) | 20) & 0xFu; }
#define XB_SPIN(cond, bar) do { unsigned _sp = 0; while (cond) { __builtin_amdgcn_s_sleep(1); \
    if ((++_sp & 255u) == 0u) { if (xb_ld(&(bar)[XB_TMO])) break; if (_sp > XB_SPIN_CAP) { atomicAdd(&(bar)[XB_TMO], 1u); break; } } } } while (0)
struct XcdBarrier { unsigned* bar; unsigned x; volatile LAS unsigned* st; };
__device__ __forceinline__ XcdBarrier xcd_barrier_post(unsigned* bar, volatile LAS unsigned* st) {
    XcdBarrier b; b.bar = bar; b.x = xb_xcc_id(); b.st = st;
    if (threadIdx.x == 0) (void)xb_add(&bar[XB_XCNT(b.x)], 1u);
    return b;
}
__device__ __forceinline__ void xcd_barrier_complete(unsigned* bar, unsigned x, unsigned& nloc, unsigned& nx) {
    const unsigned G = gridDim.x * gridDim.y * gridDim.z;
    unsigned sum, cnt, mine, sp = 0u;
    for (;;) {
        sum = 0u; cnt = 0u; mine = 0u;
#pragma unroll
        for (unsigned j = 0; j < 16; ++j) { const unsigned c = xb_ld(&bar[XB_XCNT(j)]); sum += c; cnt += (c > 0u) ? 1u : 0u; mine = (j == x) ? c : mine; }
        if (sum == G) break;
        __builtin_amdgcn_s_sleep(1);
        if ((++sp & 255u) == 0u) { if (xb_ld(&bar[XB_TMO])) break; if (sp > XB_SPIN_CAP) { atomicAdd(&bar[XB_TMO], 1u); break; } }
    }
    nloc = mine > 0u ? mine : 1u; nx = cnt > 0u ? cnt : 1u;
}
__device__ __forceinline__ void xcd_barrier_census(const XcdBarrier& b) {
    if (threadIdx.x < 64 && b.st[0] == 0u) {
        const unsigned G = gridDim.x * gridDim.y * gridDim.z; const int lane = threadIdx.x; unsigned sp = 0u, c = 0u;
        for (;;) {
            c = (lane < 16) ? xb_ld(&b.bar[XB_XCNT(lane)]) : 0u;
            unsigned sum = c;
#pragma unroll
            for (int o = 1; o < 16; o <<= 1) sum += (unsigned)__shfl_xor((int)sum, o);
            sum = (unsigned)__shfl((int)sum, 0);
            if (sum == G) break;
            __builtin_amdgcn_s_sleep(1);
            if ((++sp & 255u) == 0u) { if (xb_ld(&b.bar[XB_TMO])) break; if (sp > XB_SPIN_CAP) { if (lane == 0) atomicAdd(&b.bar[XB_TMO], 1u); break; } }
        }
        const unsigned long long nz = BALLOT(c > 0u); const unsigned mine = (unsigned)__shfl((int)c, (int)b.x);
        if (lane == 0) { b.st[0] = mine > 0u ? mine : 1u; b.st[1] = (unsigned)POPCLL(nz) > 0u ? (unsigned)POPCLL(nz) : 1u; }
    }
}
__device__ __forceinline__ void xcd_barrier(const XcdBarrier& b) {
    asm volatile("s_waitcnt vmcnt(0)" ::: "memory");
    __syncthreads();
    xcd_barrier_census(b);
    if (threadIdx.x == 0) {
        unsigned* bar = b.bar;
        __builtin_amdgcn_s_waitcnt(0);
        unsigned nloc = b.st[0], nx = b.st[1];
        if (nloc == 0u) { xcd_barrier_complete(bar, b.x, nloc, nx); b.st[0] = nloc; b.st[1] = nx; }
        const unsigned old = xb_add(&bar[XB_XSUB(b.x)], 1u);
        const unsigned gen = old / nloc;
        if (old + 1u == (gen + 1u) * nloc) {
            __builtin_amdgcn_fence(__ATOMIC_RELEASE, "agent");
            asm volatile("s_waitcnt vmcnt(0)" ::: "memory");
            const unsigned og = xb_add(&bar[XB_TOP], 1u);
            const unsigned tg = og / nx;
            if (og + 1u == (tg + 1u) * nx) xb_add(&bar[XB_TOPGEN], 1u);
            else XB_SPIN(xb_ld(&bar[XB_TOPGEN]) == tg, bar);
            __builtin_amdgcn_fence(__ATOMIC_ACQUIRE, "agent");
            xb_add(&bar[XB_XGEN(b.x)], 1u);
            asm volatile("s_waitcnt vmcnt(0)" ::: "memory");
        } else {
            XB_SPIN(xb_ld(&bar[XB_XGEN(b.x)]) == gen, bar);
            __builtin_amdgcn_fence(__ATOMIC_ACQUIRE, "agent");
            asm volatile("s_waitcnt vmcnt(0)" ::: "memory");
        }
    }
    __syncthreads();
}
#endif

struct Params {
    const float *x, *c, *ctx, *c_ctx, *w_ada, *b_ada, *w_in, *conv_w, *m_bias_i, *m_bias_f, *m_norm_w, *r_w0, *r_wB, *r_a0, *r_aB, *r_gB, *r_kk, *r_ka, *r_bonus,
        *r_norm_w, *r_norm_b, *w_out, *ln1_g, *ln1_b, *ln2_g, *ln2_b, *rt_g, *rt_g_b, *rt_e, *rt_e_b, *ex_gate, *ex_up, *ex_down;
    float* out; unsigned char* ws;
};

constexpr int CT_N = 256, CT_LD = CT_N + 1;
__device__ __forceinline__ void cvt_tile(const float* __restrict__ src, bf16_t* __restrict__ dst, int K, int N, int rows_out, int map_mode, int n0, int k0, float* tile, int tid) {
    __syncthreads();
    { const int n4 = (tid & 63) * 4, kb = tid >> 6, n = n0 + n4; const bool ok = n < N; const int nc = ok ? n : 0;
#pragma unroll
      for (int i = 0; i < 8; ++i) { const int kk = kb + 8 * i; f32x4 v = *(const f32x4*)(src + (size_t)(k0 + kk) * N + nc); if (!ok) v = (f32x4){0.f, 0.f, 0.f, 0.f};
          tile[kk * CT_LD + n4] = v[0]; tile[kk * CT_LD + n4 + 1] = v[1]; tile[kk * CT_LD + n4 + 2] = v[2]; tile[kk * CT_LD + n4 + 3] = v[3]; } }
    __syncthreads();
#pragma unroll
    for (int j = 0; j < 4; ++j) { const int o = tid + NTHREADS * j, nn = o >> 3, kg = (o & 7) * 8, n = n0 + nn; int row; bool ok;
        if (map_mode == 0) { row = n; ok = row < rows_out; } else { ok = n < N; row = 32 * (n / 16) + 16 * (map_mode - 1) + (n % 16); }
        if (ok) { const float* tp = tile + kg * CT_LD + nn; u32x4 w; w.x = pack_bf16(tp[0], tp[CT_LD]); w.y = pack_bf16(tp[2 * CT_LD], tp[3 * CT_LD]); w.z = pack_bf16(tp[4 * CT_LD], tp[5 * CT_LD]); w.w = pack_bf16(tp[6 * CT_LD], tp[7 * CT_LD]);
            *(u32x4*)(dst + (size_t)row * K + k0 + kg) = w; } }
}
__device__ __forceinline__ void phase_prologue(const Params& p, unsigned char* smem) {
    float* sf = (float*)smem;
    int tid = threadIdx.x; OPAQUE(tid); const int G = gridDim.x;
    float* mod = (float*)(p.ws + WS_MOD);
    constexpr int NJB = 6 * D_MODEL / NTHREADS, N_MODVB = (BATCH + 1) * NJB;
    constexpr int NT_WIN = (IN_PAD / CT_N) * (D_MODEL / 64), NT_WOUT = (D_MODEL / CT_N) * (MIX_W / 64);
    constexpr int TG = (D_EXPERT / CT_N) * (D_MODEL / 64), TD = (D_MODEL / CT_N) * (D_EXPERT / 64), NT_EXP = N_EXPERTS * (2 * TG + TD);
    constexpr int NT_GBT = (W_R * GK) / (NTHREADS * 8);
    static_assert(D_EXPERT % CT_N == 0 && D_MODEL % CT_N == 0 && (W_R * GK) % (NTHREADS * 8) == 0, "tile shapes");
    for (int vb = blockIdx.x; vb < N_MODVB + NT_WIN + NT_WOUT + NT_EXP + NT_GBT; vb += G) {
        if (vb < N_MODVB) {
            const int r = vb / NJB, j = (vb % NJB) * NTHREADS + tid;
            const float* src = (r < BATCH) ? p.c + (size_t)r * D_MODEL : p.c_ctx;
            __syncthreads();
            for (int k = tid; k < D_MODEL; k += NTHREADS) sf[k] = siluf_(src[k]);
            __syncthreads();
            float acc0 = 0.f, acc1 = 0.f, acc2 = 0.f, acc3 = 0.f;
            for (int k = 0; k < D_MODEL; k += 4) { acc0 += sf[k] * p.w_ada[(size_t)k * (6 * D_MODEL) + j]; acc1 += sf[k + 1] * p.w_ada[(size_t)(k + 1) * (6 * D_MODEL) + j];
                acc2 += sf[k + 2] * p.w_ada[(size_t)(k + 2) * (6 * D_MODEL) + j]; acc3 += sf[k + 3] * p.w_ada[(size_t)(k + 3) * (6 * D_MODEL) + j]; }
            mod[(size_t)r * 6 * D_MODEL + j] = (acc0 + acc1) + (acc2 + acc3) + p.b_ada[j];
        } else if (vb < N_MODVB + NT_WIN) {
            const int t = vb - N_MODVB; cvt_tile(p.w_in, (bf16_t*)(p.ws + WS_WIN), D_MODEL, IN_COLS, IN_PAD, 0, (t % (IN_PAD / CT_N)) * CT_N, (t / (IN_PAD / CT_N)) * 64, sf, tid);
        } else if (vb < N_MODVB + NT_WIN + NT_WOUT) {
            const int t = vb - N_MODVB - NT_WIN; cvt_tile(p.w_out, (bf16_t*)(p.ws + WS_WOUT), MIX_W, D_MODEL, D_MODEL, 0, (t % (D_MODEL / CT_N)) * CT_N, (t / (D_MODEL / CT_N)) * 64, sf, tid);
        } else if (vb < N_MODVB + NT_WIN + NT_WOUT + NT_EXP) {
            const int v2 = vb - N_MODVB - NT_WIN - NT_WOUT, e = v2 / (2 * TG + TD), r = v2 % (2 * TG + TD);
            bf16_t* wgu = (bf16_t*)(p.ws + WS_WGU); bf16_t* wdn = (bf16_t*)(p.ws + WS_WDN);
            if (r < 2 * TG) { const int which = r / TG, t = r % TG;
                cvt_tile((which ? p.ex_up : p.ex_gate) + (size_t)e * D_MODEL * D_EXPERT, wgu + (size_t)e * 2 * D_EXPERT * D_MODEL, D_MODEL, D_EXPERT, 2 * D_EXPERT, 1 + which,
                         (t % (D_EXPERT / CT_N)) * CT_N, (t / (D_EXPERT / CT_N)) * 64, sf, tid);
            } else { const int t = r - 2 * TG;
                cvt_tile(p.ex_down + (size_t)e * D_EXPERT * D_MODEL, wdn + (size_t)e * D_MODEL * D_EXPERT, D_EXPERT, D_MODEL, D_MODEL, 0, (t % (D_MODEL / CT_N)) * CT_N, (t / (D_MODEL / CT_N)) * 64, sf, tid); }
        } else {
            const int t = vb - N_MODVB - NT_WIN - NT_WOUT - NT_EXP; bf16_t* gbt = (bf16_t*)(p.ws + WS_GBT);
            const int o = (t * NTHREADS + tid) * 8, n = o / GK, k0 = o % GK; u32x4 w = (u32x4){0u, 0u, 0u, 0u};
            if (k0 >= GK - G_LORA) { const float* gp = p.r_gB + (size_t)(k0 - (GK - G_LORA)) * W_R + n;
                w.x = pack_bf16(gp[0], gp[W_R]); w.y = pack_bf16(gp[2 * W_R], gp[3 * W_R]); w.z = pack_bf16(gp[4 * W_R], gp[5 * W_R]); w.w = pack_bf16(gp[6 * W_R], gp[7 * W_R]); }
            *(u32x4*)(gbt + o) = w;
        }
    }
}

constexpr int NV4 = D_MODEL / 256;
__device__ __forceinline__ void phase_ln_mod(const Params& p) {
    int tid = threadIdx.x; OPAQUE(tid); const int lane = tid & 63, wid = tid >> 6;
    const float* mod = (const float*)(p.ws + WS_MOD); bf16_t* h = (bf16_t*)(p.ws + WS_H);
    const int stride = gridDim.x * NWAVES;
    f32x4 nv[NV4];
#define LM_LOAD(gg) do { const int _b = (gg) / T_ALL, _t = (gg) % T_ALL; \
        const float* _src = (_t < CTX_LEN) ? p.ctx + ((size_t)_b * CTX_LEN + _t) * D_MODEL : p.x + ((size_t)_b * SEQ + (_t - CTX_LEN)) * D_MODEL; \
        _Pragma("unroll") for (int i = 0; i < NV4; ++i) nv[i] = *(const f32x4*)(_src + 4 * lane + 256 * i); } while (0)
    if (blockIdx.x * NWAVES + wid < NTOK) LM_LOAD(blockIdx.x * NWAVES + wid);
    for (int g = blockIdx.x * NWAVES + wid; g < NTOK; g += stride) {
        const int b = g / T_ALL, t = g % T_ALL;
        const float* m = mod + (size_t)((t < CTX_LEN) ? BATCH : b) * 6 * D_MODEL;
        f32x4 v[NV4]; float s = 0.f;
#pragma unroll
        for (int i = 0; i < NV4; ++i) { v[i] = nv[i]; s += (v[i][0] + v[i][1]) + (v[i][2] + v[i][3]); }
        f32x4 shv[NV4], scv[NV4];
#pragma unroll
        for (int i = 0; i < NV4; ++i) { const int k = 4 * lane + 256 * i; shv[i] = *(const f32x4*)(m + k); scv[i] = *(const f32x4*)(m + D_MODEL + k); }
        LM_LOAD(g + stride < NTOK ? g + stride : g);
        const float mu = wave_sum(s) * (1.0f / D_MODEL);
        float q = 0.f;
#pragma unroll
        for (int i = 0; i < NV4; ++i) { const f32x4 d = v[i] - mu; q += (d[0] * d[0] + d[1] * d[1]) + (d[2] * d[2] + d[3] * d[3]); }
        const float rstd = rsqrtf(wave_sum(q) * (1.0f / D_MODEL) + LN_EPS);
#pragma unroll
        for (int i = 0; i < NV4; ++i) { const int k = 4 * lane + 256 * i; const f32x4 sh = shv[i], sc = scv[i];
            const f32x4 o = (v[i] - mu) * rstd * (sc + 1.0f) + sh; u32x2 w; w.x = pack_bf16(o[0], o[1]); w.y = pack_bf16(o[2], o[3]);
            *(u32x2*)(h + (size_t)g * D_MODEL + k) = w; }
    }
#undef LM_LOAD
}

__device__ __forceinline__ int chunk_t0(int d, int c) {
    if (d == 0) return 64 * c;
    if (c < NC_CTX) return CTX_LEN - 64 * (c + 1);
    return CTX_LEN + SEQ - 64 * (c - NC_CTX + 1);
}

constexpr int LP = 72;
__device__ __forceinline__ void unpack8(const u32x4 w, float (&f)[8]) {
    f[0] = __builtin_bit_cast(float, w.x << 16); f[1] = __builtin_bit_cast(float, w.x & 0xffff0000u); f[2] = __builtin_bit_cast(float, w.y << 16); f[3] = __builtin_bit_cast(float, w.y & 0xffff0000u);
    f[4] = __builtin_bit_cast(float, w.z << 16); f[5] = __builtin_bit_cast(float, w.z & 0xffff0000u); f[6] = __builtin_bit_cast(float, w.w << 16); f[7] = __builtin_bit_cast(float, w.w & 0xffff0000u);
}
constexpr int CV_BAND = 4;
__device__ __forceinline__ u32x4 conv_post_pack(float (&acc)[8], int col0) {
    if (col0 < 2 * W_M) { const float sc = (col0 >= W_M) ? 0.125f : 1.0f;
#pragma unroll
        for (int j = 0; j < 8; ++j) acc[j] = siluf_(acc[j]) * sc; }
    u32x4 w; w.x = pack_bf16(acc[0], acc[1]); w.y = pack_bf16(acc[2], acc[3]); w.z = pack_bf16(acc[4], acc[5]); w.w = pack_bf16(acc[6], acc[7]); return w;
}
__device__ __forceinline__ void phase_conv(const Params& p, unsigned char* smem, bool dry) {
    constexpr int IMG = 6 * 66 * 8;
    u32x4* img = (u32x4*)smem;
    float* wl = (float*)(smem + (size_t)2 * IMG * 16);
    float* cwl = wl + 2 * 576;
    int tid = threadIdx.x; OPAQUE(tid); const int G = gridDim.x;
    bf16_t* Pc = (bf16_t*)(p.ws + WS_PC); bf16_t* Pt = (bf16_t*)(p.ws + WS_PT); bf16_t* U = (bf16_t*)(p.ws + WS_U);
    constexpr int NSLAB = CONV_CH / 64, NBAND = BATCH * (GRID_ROWS / CV_BAND), CTX_SPLIT = 4, NCTXU = BATCH * NC_CTX * CTX_SPLIT, NCG = CONV_CH / 8, NITEM = GRID_W * NCG;
    static_assert(CV_BAND == 4 && GRID_ROWS % CV_BAND == 0 && GRID_W * 8 == NTHREADS, "conv band shapes");
    const u32x4 zero4 = (u32x4){0u, 0u, 0u, 0u};
    __syncthreads();
    for (int i = tid; i < 2 * 6 * 2 * 8; i += NTHREADS) { const int bq = i / (6 * 2 * 8), r = (i / 16) % 6, side = (i / 8) & 1, g8 = i & 7; img[bq * IMG + (r * 66 + (side ? 65 : 0)) * 8 + g8] = zero4; }
    for (int i = tid; i < 3 * CONV_CH; i += NTHREADS) cwl[i] = p.conv_w[3 * CONV_CH + i];
    __syncthreads();
    const int x = tid >> 3, cgl = tid & 7;
    for (int bd = blockIdx.x; bd < NBAND + NCTXU; bd += G) {
        if (bd < NBAND) {
            const int b = bd / (GRID_ROWS / CV_BAND), r0 = (bd % (GRID_ROWS / CV_BAND)) * CV_BAND;
            const int tokl = b * T_ALL + CTX_LEN;
            const bf16_t* ldp = Pc + pc_off(cgl * 8, tokl + x); bf16_t* stp = U + pc_off(cgl * 8, tokl + x);
            u32x4 va[6], vb[6]; f32x4 wa = (f32x4){0.f, 0.f, 0.f, 0.f}, wb = wa;
#define CV_ISSUE(V, W, sl) do { _Pragma("unroll") for (int ry = 0; ry < 6; ++ry) { const int y = r0 - 1 + ry; const bool ok = (y >= 0 && y < GRID_ROWS); \
                const u32x4 t4 = *(const u32x4*)(ldp + (size_t)(sl) * ((size_t)NTOK * 64) + (ok ? y : r0) * (GRID_W * 64)); V[ry] = t4; } \
                if (tid < 144) W = *(const f32x4*)(p.conv_w + (size_t)(tid >> 4) * CONV_CH + (sl) * 64 + (tid & 15) * 4); } while (0)
#define CV_SLAB(V, W, sl) do { \
                u32x4* im = img + ((sl) & 1) * IMG; float* wls = wl + ((sl) & 1) * 576; \
                _Pragma("unroll") for (int ry = 0; ry < 6; ++ry) { const int y = r0 - 1 + ry; im[(ry * 66 + x + 1) * 8 + cgl] = (y >= 0 && y < GRID_ROWS) ? V[ry] : zero4; } \
                if (tid < 144) *(f32x4*)(wls + (tid >> 4) * 64 + (tid & 15) * 4) = W; \
                if ((sl) + 2 < NSLAB) CV_ISSUE(V, W, (sl) + 2); \
                LDS_BAR(); \
                const int col0 = (sl) * 64 + cgl * 8; \
                float acc[4][8]; \
                _Pragma("unroll") for (int r = 0; r < 4; ++r) _Pragma("unroll") for (int j = 0; j < 8; ++j) acc[r][j] = 0.f; \
                _Pragma("unroll 1") for (int kx = 0; kx < 3; ++kx) { \
                    f32x4 w0[3], w1[3]; \
                    _Pragma("unroll") for (int ky = 0; ky < 3; ++ky) { w0[ky] = *(const f32x4*)(wls + (ky * 3 + kx) * 64 + cgl * 8); w1[ky] = *(const f32x4*)(wls + (ky * 3 + kx) * 64 + cgl * 8 + 4); } \
                    _Pragma("unroll") for (int iy = 0; iy < 6; ++iy) { float f[8]; unpack8(im[(iy * 66 + x + kx) * 8 + cgl], f);     \
                        _Pragma("unroll") for (int ky = 0; ky < 3; ++ky) { const int rp = iy - ky; if (rp >= 0 && rp < 4) { \
                            _Pragma("unroll") for (int j = 0; j < 4; ++j) { acc[rp][j] += f[j] * w0[ky][j]; acc[rp][4 + j] += f[4 + j] * w1[ky][j]; } } } } } \
                _Pragma("unroll") for (int rp = 0; rp < 4; ++rp) *(u32x4*)(stp + (size_t)(sl) * ((size_t)NTOK * 64) + (r0 + rp) * (GRID_W * 64)) = conv_post_pack(acc[rp], col0); } while (0)
            static_assert(NSLAB % 2 == 0, "slab pairs");
            CV_ISSUE(va, wa, 0); CV_ISSUE(vb, wb, 1);
            for (int sl = 0; sl < NSLAB; sl += 2) { CV_SLAB(va, wa, sl); CV_SLAB(vb, wb, sl + 1); }
#undef CV_ISSUE
#undef CV_SLAB
            if (!dry) for (int it = tid; it < CV_BAND * GRID_W * (G_LORA / 8); it += NTHREADS) {
                bf16_t* q = Pt + ((size_t)b * T_ALL + CTX_LEN + r0 * GRID_W + it / (G_LORA / 8)) * P2_LD + T_LG + (it % (G_LORA / 8)) * 8;
                float f[8]; unpack8(*(const u32x4*)q, f);
                u32x4 w; w.x = pack_bf16(sigmoidf_(f[0]), sigmoidf_(f[1])); w.y = pack_bf16(sigmoidf_(f[2]), sigmoidf_(f[3])); w.z = pack_bf16(sigmoidf_(f[4]), sigmoidf_(f[5])); w.w = pack_bf16(sigmoidf_(f[6]), sigmoidf_(f[7]));
                *(u32x4*)q = w; }
            __syncthreads();
        } else {
            const int cu3 = bd - NBAND, cu2 = cu3 / CTX_SPLIT, part = cu3 % CTX_SPLIT, b = cu2 / NC_CTX, t00 = (cu2 % NC_CTX) * 64;
            const int tokb = b * T_ALL;
            for (int it = part * (NITEM / CTX_SPLIT) + tid; it < (part + 1) * (NITEM / CTX_SPLIT); it += NTHREADS) {
                const int i = it / NCG, col0 = (it % NCG) * 8, t = t00 + i; float acc[8];
#pragma unroll
                for (int j = 0; j < 8; ++j) acc[j] = 0.f;
#pragma unroll
                for (int kx = 0; kx < 3; ++kx) { const int tt = t + kx - 1; const bool ok = (tt >= 0 && tt < CTX_LEN);
                    const u32x4 raw = *(const u32x4*)(Pc + pc_off(col0, tokb + (ok ? tt : t))); float f[8]; unpack8(ok ? raw : zero4, f);
                    const f32x4 w0 = *(const f32x4*)(cwl + kx * CONV_CH + col0), w1 = *(const f32x4*)(cwl + kx * CONV_CH + col0 + 4);
#pragma unroll
                    for (int j = 0; j < 4; ++j) { acc[j] += f[j] * w0[j]; acc[4 + j] += f[4 + j] * w1[j]; } }
                *(u32x4*)(U + pc_off(col0, tokb + t)) = conv_post_pack(acc, col0);
            }
        }
    }
}

constexpr int SL = 32, LT = 40;
constexpr int TSJ = 64 * LT + 32;
#define TROW(r) ((r) * LT + ((r) >> 5) * 32)
#define TBLK(r, b) ((((b) ^ ((r) >> 3)) & 3) << 3)
__device__ __forceinline__ void rwkv_job(const Params& p, int job, unsigned char* smem) {
    float* Lam = (float*)smem;
    float* a_s = Lam + 4096;
    bf16_t* Aw = (bf16_t*)(a_s + 4096); bf16_t* Aa = Aw + 64 * LP; bf16_t* Bw = Aa + 64 * LP; bf16_t* Ba = Bw + 64 * LP;
    bf16_t* Amat = Ba + 64 * LP; bf16_t* Bmat = Amat + 64 * LP; bf16_t* Cmat = Bmat + 64 * LP; bf16_t* Rmat = Cmat + 64 * LP;
    bf16_t* BmT = Rmat + 64 * LP; bf16_t* CmT = BmT + 2 * TSJ; bf16_t* VmT = CmT + 2 * TSJ;
    float* WL = (float*)(VmT + 2 * TSJ);
    float* segtot = WL + 128;
    float* kcst = segtot + 512;
    bf16_t* Umat = (bf16_t*)Lam; bf16_t* Sb = Umat + 64 * LT;
    bf16_t* NcaT = (bf16_t*)a_s; bf16_t* NcrT = NcaT + 2 * SL * LT; bf16_t* NbrT = NcrT + 2 * SL * LT;
    float* NbaT = (float*)Aw; float* RHS = NbaT + 2 * SL * 36;
    static_assert(64 * LT * 2 + 64 * LP * 2 <= 4096 * 4 && 3 * 2 * SL * LT * 2 <= 4096 * 4 && (2 * SL * 36 + 64 * 36) * 4 <= 2 * 64 * LP * 2, "rwkv LDS aliases");
    const bf16_t* P = (const bf16_t*)(p.ws + WS_P); const bf16_t* U = (const bf16_t*)(p.ws + WS_U);
    int tid = threadIdx.x; OPAQUE(tid);
    const int lane = tid & 63, wid = RFL(tid >> 6), l15 = lane & 15, lq = lane >> 4;
    const int z = job / H_R, h = job % H_R, d = z / BATCH, b = z % BATCH;
    const int hc0 = h * 64;
    const bf16_t* Ptb = (const bf16_t*)(p.ws + WS_PT) + (size_t)b * T_ALL * P2_LD; const int tokb = b * T_ALL;
    bf16_t* Pcw = (bf16_t*)(p.ws + WS_PC);
    const int ycol = (d ? OFF_RK : OFF_RR) + hc0;
    __syncthreads();
    for (int idx = tid; idx < 4096; idx += NTHREADS) { const int j = idx >> 6, ch = idx & 63;
        Bw[ch * LP + j] = f2bf(p.r_wB[((size_t)d * W_LORA + j) * W_R + hc0 + ch]); Ba[ch * LP + j] = f2bf(p.r_aB[(size_t)j * W_R + hc0 + ch]); }
    if (tid < 192) kcst[tid] = (tid < 64 ? p.r_kk : tid < 128 ? p.r_ka : p.r_bonus)[hc0 + (tid & 63)];
    const int pi = tid >> 3, cg = tid & 7, c0 = cg * 8;
    const int ppi = d ? 63 - pi : pi, sj = ppi >> 5, st = ppi & 31;
    const int kb = wid & 3, vb0 = 2 * (wid >> 2);
    f32x4 ST[2];
    ST[0] = (f32x4){0.f, 0.f, 0.f, 0.f}; ST[1] = (f32x4){0.f, 0.f, 0.f, 0.f};
    u32x4 n_lwv, n_lav, n_rr, n_rk, n_rv;
#define RW_PREFETCH(cn) do { const int _t = chunk_t0(d, (cn)) + pi; const bf16_t* _pr = Ptb + (size_t)_t * P2_LD; \
        n_lwv = *(const u32x4*)(_pr + (d ? T_LWB : T_LWF) + c0); n_lav = *(const u32x4*)(_pr + T_LA + c0); \
        n_rr = *(const u32x4*)(U + pc_off(OFF_RR + hc0 + c0, tokb + _t)); n_rk = *(const u32x4*)(U + pc_off(OFF_RK + hc0 + c0, tokb + _t)); n_rv = *(const u32x4*)(U + pc_off(OFF_RV + hc0 + c0, tokb + _t)); } while (0)
    RW_PREFETCH(0);
    float lbias[4];
#pragma unroll
    for (int cb = 0; cb < 4; ++cb) lbias[cb] = (wid >> 2) ? p.r_a0[hc0 + cb * 16 + l15] : p.r_w0[d * W_R + hc0 + cb * 16 + l15];
#pragma unroll
    for (int cb = 0; cb < 4; ++cb) OPAQUE(lbias[cb]);
    u32x2 ypend0 = (u32x2){0u, 0u}, ypend1 = (u32x2){0u, 0u};
#define RW_STORE_Y(cc) do { const int _t0 = chunk_t0(d, (cc)), _vb = wid >> 1, _tb = wid & 1; _Pragma("unroll") for (int _j = 0; _j < 2; ++_j) { const int _pp = _j * SL + _tb * 16 + l15, _tt = _t0 + (d ? 63 - _pp : _pp); \
            if (_tt >= CTX_LEN) *(u32x2*)(Pcw + pc_off(ycol + _vb * 16 + lq * 4, tokb + _tt)) = _j ? ypend1 : ypend0; } } while (0)
    for (int c = 0; c < NC_ALL; ++c) {
        const int t0 = chunk_t0(d, c), t = t0 + pi;
        LDS_BAR();
#ifdef HIP_EMU_POISON
        { unsigned* ps = (unsigned*)smem; const int lo0 = 0, hi0 = (int)(((unsigned char*)Bw - smem) / 4), lo1 = (int)(((unsigned char*)Amat - smem) / 4), hi1 = (int)(((unsigned char*)(segtot + 512) - smem) / 4);
          for (int i = lo0 + tid; i < hi0; i += NTHREADS) ps[i] = 0xFFFFFFFFu; for (int i = lo1 + tid; i < hi1; i += NTHREADS) ps[i] = 0xFFFFFFFFu; }
        LDS_BAR();
#endif
        float racc[8], kacc[8], vacc[8];
        {
            const u32x4 lwv = n_lwv, lav = n_lav, rr = n_rr, rk = n_rk, rv = n_rv;
            float f[8]; unpack8(lwv, f);
            u32x4 tw; tw.x = pack_bf16(ftanh(f[0]), ftanh(f[1])); tw.y = pack_bf16(ftanh(f[2]), ftanh(f[3])); tw.z = pack_bf16(ftanh(f[4]), ftanh(f[5])); tw.w = pack_bf16(ftanh(f[6]), ftanh(f[7]));
            *(u32x4*)(Aw + pi * LP + c0) = tw; *(u32x4*)(Aa + pi * LP + c0) = lav;
            unpack8(rr, racc); unpack8(rk, kacc); unpack8(rv, vacc);
            bf16_t* vt = VmT + sj * TSJ + TROW(c0) + TBLK(c0, st >> 3) + (st & 7);
            vt[0] = (bf16_t)(rv.x & 0xffff); vt[LT] = (bf16_t)(rv.x >> 16); vt[2 * LT] = (bf16_t)(rv.y & 0xffff); vt[3 * LT] = (bf16_t)(rv.y >> 16);
            vt[4 * LT] = (bf16_t)(rv.z & 0xffff); vt[5 * LT] = (bf16_t)(rv.z >> 16); vt[6 * LT] = (bf16_t)(rv.w & 0xffff); vt[7 * LT] = (bf16_t)(rv.w >> 16);
            if (c > 0) RW_STORE_Y(c - 1);
        }
        LDS_BAR();
        for (int rep2 = 0; rep2 < REP_RW_S2; ++rep2)
        {
            const int path = wid >> 2, tb = wid & 3; const bf16_t* A = path ? Aa : Aw; const bf16_t* B = path ? Ba : Bw;
            f32x4 acc[4];
#pragma unroll
            for (int cb = 0; cb < 4; ++cb) acc[cb] = (f32x4){0.f, 0.f, 0.f, 0.f};
#pragma unroll
            for (int kk = 0; kk < 2; ++kk) { const bf16x8 af = *(const bf16x8*)(A + (tb * 16 + l15) * LP + kk * 32 + lq * 8);
#pragma unroll
                for (int cb = 0; cb < 4; ++cb) { const bf16x8 bfr = *(const bf16x8*)(B + (cb * 16 + l15) * LP + kk * 32 + lq * 8); acc[cb] = MFMA16(af, bfr, acc[cb]); } }
#pragma unroll
            for (int cb = 0; cb < 4; ++cb) { const int ch = cb * 16 + l15;
                const float bias = lbias[cb];
                float val[4];
#pragma unroll
                for (int r = 0; r < 4; ++r) val[r] = sigmoidf_(acc[cb][r] + bias);
                if (path) {
#pragma unroll
                    for (int r = 0; r < 4; ++r) { const int tok = tb * 16 + lq * 4 + r, pp = d ? 63 - tok : tok; a_s[pp * 64 + ch] = val[r]; } }
                else {
                    float tot;
#pragma unroll
                    for (int r = 0; r < 4; ++r) val[r] *= -DECAY_SCALE;
                    if (!d) { val[1] += val[0]; val[2] += val[1]; val[3] += val[2]; tot = val[3]; } else { val[2] += val[3]; val[1] += val[2]; val[0] += val[1]; tot = val[0]; }
                    float inc = tot;
                    { const float t1 = d ? __shfl_down(inc, 16) : __shfl_up(inc, 16); inc += (d ? lq < 3 : lq > 0) ? t1 : 0.f; }
                    { const float t2 = d ? __shfl_down(inc, 32) : __shfl_up(inc, 32); inc += (d ? lq < 2 : lq > 1) ? t2 : 0.f; }
                    const float excl = inc - tot;
#pragma unroll
                    for (int r = 0; r < 4; ++r) { const int tok = tb * 16 + lq * 4 + r, pp = d ? 63 - tok : tok; Lam[pp * 64 + ch] = val[r] + excl; }
                    if (lq == (d ? 0 : 3)) segtot[(d ? 3 - tb : tb) * 64 + ch] = inc;
                } }
        }
        LDS_BAR();
        for (int rep3 = 0; rep3 < REP_RW_S3; ++rep3)
        {
            float off[8];
            {   const bool second = (ppi & 16) != 0; const f32x4 x0 = *(const f32x4*)(segtot + ((ppi >> 4) & ~1) * 64 + c0), x1 = *(const f32x4*)(segtot + ((ppi >> 4) & ~1) * 64 + c0 + 4);
#pragma unroll
                for (int j = 0; j < 4; ++j) { off[j] = second ? x0[j] : 0.f; off[4 + j] = second ? x1[j] : 0.f; } }
            const f32x4 l0 = *(const f32x4*)(Lam + ppi * 64 + c0), l1 = *(const f32x4*)(Lam + ppi * 64 + c0 + 4);
            const bool first = (ppi & 15) == 0; const int ppm = first ? ppi : ppi - 1;
            const f32x4 m0 = *(const f32x4*)(Lam + ppm * 64 + c0), m1 = *(const f32x4*)(Lam + ppm * 64 + c0 + 4);
            const f32x4 a0 = *(const f32x4*)(a_s + ppi * 64 + c0), a1 = *(const f32x4*)(a_s + ppi * 64 + c0 + 4);
            const f32x4 kk0 = *(const f32x4*)(kcst + c0), kk1 = *(const f32x4*)(kcst + c0 + 4), ka0 = *(const f32x4*)(kcst + 64 + c0), ka1 = *(const f32x4*)(kcst + 64 + c0 + 4);
            const f32x4 bw0 = *(const f32x4*)(kcst + 128 + c0), bw1 = *(const f32x4*)(kcst + 128 + c0 + 4);
            float lam[8], lprev[8], av[8], kkv[8], kav[8], bwv[8];
#pragma unroll
            for (int j = 0; j < 4; ++j) { lam[j] = l0[j] + off[j]; lam[4 + j] = l1[j] + off[4 + j];
                lprev[j] = (first ? 0.f : m0[j]) + off[j]; lprev[4 + j] = (first ? 0.f : m1[j]) + off[4 + j];
                av[j] = a0[j]; av[4 + j] = a1[j]; kkv[j] = kk0[j]; kkv[4 + j] = kk1[j]; kav[j] = ka0[j]; kav[4 + j] = ka1[j]; bwv[j] = bw0[j]; bwv[4 + j] = bw1[j]; }
            float kap[8], ss = 0.f;
#pragma unroll
            for (int j = 0; j < 8; ++j) { kap[j] = kacc[j] * kkv[j]; ss += kap[j] * kap[j]; }
            ss = red8(ss);
            const float inv = frsq(fmaxf(ss, 1e-24f));
            float am[8], bm[8], cm[8], rm[8], bon = 0.f;
#pragma unroll
            for (int j = 0; j < 8; ++j) { const float wv = fexp(lam[j]), wp = fexp(lprev[j]), wi = frcp(wv);
                const float kh = kap[j] * inv, km = kacc[j] * (1.0f + (av[j] - 1.0f) * kav[j]);
                am[j] = wp * kh; bm[j] = kh * av[j] * wi; cm[j] = km * wi; rm[j] = racc[j] * wv; bon += racc[j] * km * bwv[j];
                if (st == SL - 1) WL[sj * 64 + c0 + j] = wv; }
            bon = red8(bon);
            u32x4 w; w.x = pack_bf16(am[0], am[1]); w.y = pack_bf16(am[2], am[3]); w.z = pack_bf16(am[4], am[5]); w.w = pack_bf16(am[6], am[7]); *(u32x4*)(Amat + ppi * LP + c0) = w;
            u32x4 bw4, cw4;
            bw4.x = pack_bf16(bm[0], bm[1]); bw4.y = pack_bf16(bm[2], bm[3]); bw4.z = pack_bf16(bm[4], bm[5]); bw4.w = pack_bf16(bm[6], bm[7]); *(u32x4*)(Bmat + ppi * LP + c0) = bw4;
            cw4.x = pack_bf16(cm[0], cm[1]); cw4.y = pack_bf16(cm[2], cm[3]); cw4.z = pack_bf16(cm[4], cm[5]); cw4.w = pack_bf16(cm[6], cm[7]); *(u32x4*)(Cmat + ppi * LP + c0) = cw4;
            w.x = pack_bf16(rm[0], rm[1]); w.y = pack_bf16(rm[2], rm[3]); w.z = pack_bf16(rm[4], rm[5]); w.w = pack_bf16(rm[6], rm[7]); *(u32x4*)(Rmat + ppi * LP + c0) = w;
            const int toff = sj * TSJ + TROW(c0) + TBLK(c0, st >> 3) + (st & 7); bf16_t* bt = BmT + toff; bf16_t* ct = CmT + toff;
#pragma unroll
            for (int j2 = 0; j2 < 4; ++j2) { const unsigned nb = bw4[j2] ^ 0x80008000u, cc = cw4[j2];
                bt[(2 * j2) * LT] = (bf16_t)(nb & 0xffff); bt[(2 * j2 + 1) * LT] = (bf16_t)(nb >> 16); ct[(2 * j2) * LT] = (bf16_t)(cc & 0xffff); ct[(2 * j2 + 1) * LT] = (bf16_t)(cc >> 16); }
            if (d == 0 && t >= CTX_LEN) { w.x = pack_bf16(bon * vacc[0], bon * vacc[1]); w.y = pack_bf16(bon * vacc[2], bon * vacc[3]); w.z = pack_bf16(bon * vacc[4], bon * vacc[5]); w.w = pack_bf16(bon * vacc[6], bon * vacc[7]);
                *(u32x4*)(Pcw + pc_off(OFF_RV + hc0 + c0, tokb + t)) = w; }
        }
        LDS_BAR();
        RW_PREFETCH(c + 1 < NC_ALL ? c + 1 : c);
        for (int rep5 = 0; rep5 < REP_RW_MM; ++rep5)
        {
            const int j = wid >> 2, mt = wid & 3;
            const bf16_t* Arow = ((mt == 0 || mt == 3) ? Bmat : Cmat) + j * SL * LP; const bf16_t* Brow = ((mt <= 1) ? Amat : Rmat) + j * SL * LP;
            bf16x8 afr[2][2], bfr[2][2];
#pragma unroll
            for (int b2 = 0; b2 < 2; ++b2)
#pragma unroll
                for (int kk = 0; kk < 2; ++kk) { afr[b2][kk] = *(const bf16x8*)(Arow + (b2 * 16 + l15) * LP + kk * 32 + lq * 8); bfr[b2][kk] = *(const bf16x8*)(Brow + (b2 * 16 + l15) * LP + kk * 32 + lq * 8); }
            f32x4 acc4[2][2];
#pragma unroll
            for (int sb = 0; sb < 2; ++sb)
#pragma unroll
                for (int tb = 0; tb < 2; ++tb) { acc4[sb][tb] = (f32x4){0.f, 0.f, 0.f, 0.f};
#pragma unroll
                    for (int kk = 0; kk < 2; ++kk) acc4[sb][tb] = MFMA16(afr[sb][kk], bfr[tb][kk], acc4[sb][tb]); }
#pragma unroll
            for (int sb = 0; sb < 2; ++sb)
#pragma unroll
                for (int tb = 0; tb < 2; ++tb) {
                    const f32x4 acc = acc4[sb][tb];
                    const int tt = tb * 16 + l15, s0 = sb * 16 + lq * 4;
                    float vals[4];
#pragma unroll
                    for (int r = 0; r < 4; ++r) { const int ss2 = s0 + r; const bool keep = (mt <= 1) ? (ss2 < tt) : (ss2 <= tt); vals[r] = keep ? acc[r] : 0.f; }
                    if (mt == 0) {
#pragma unroll
                        for (int r = 0; r < 4; ++r) NbaT[(j * SL + s0 + r) * 36 + (tt & 3) * 8 + (tt >> 2)] = -vals[r]; }
                    else { bf16_t* dst = (mt == 1 ? NcaT : mt == 2 ? NcrT : NbrT) + (j * SL + tt) * LT + s0; const float sgn = (mt == 3) ? -1.f : 1.f;
                        u32x2 w; w.x = pack_bf16(sgn * vals[0], sgn * vals[1]); w.y = pack_bf16(sgn * vals[2], sgn * vals[3]); *(u32x2*)dst = w; }
                }
        }
        {
#pragma unroll
            for (int q = 0; q < 2; ++q) { u32x2 w; w.x = pack_bf16(ST[q][0], ST[q][1]); w.y = pack_bf16(ST[q][2], ST[q][3]);
                *(u32x2*)(Sb + ((vb0 + q) * 16 + l15) * LP + kb * 16 + lq * 4) = w; }
        }
#pragma unroll 1
        for (int j = 0; j < 2; ++j) {
            LDS_BAR();
            f32x4 yacc = (f32x4){0.f, 0.f, 0.f, 0.f};
            for (int rep6 = 0; rep6 < REP_RW_ST2; ++rep6)
            {
                const int vb = wid >> 1, tb = wid & 1; f32x4 acc = (f32x4){0.f, 0.f, 0.f, 0.f}; yacc = (f32x4){0.f, 0.f, 0.f, 0.f};
#pragma unroll
                for (int kk = 0; kk < 2; ++kk) { const bf16x8 af = *(const bf16x8*)(Sb + (vb * 16 + l15) * LP + kk * 32 + lq * 8), bfr = *(const bf16x8*)(Amat + (j * SL + tb * 16 + l15) * LP + kk * 32 + lq * 8);
                    const bf16x8 rfr = *(const bf16x8*)(Rmat + (j * SL + tb * 16 + l15) * LP + kk * 32 + lq * 8);
                    acc = MFMA16(af, bfr, acc); yacc = MFMA16(af, rfr, yacc); }
                { const bf16x8 af = *(const bf16x8*)(VmT + j * TSJ + TROW(vb * 16 + l15) + TBLK(vb * 16 + l15, lq)), bfr = *(const bf16x8*)(NcaT + (j * SL + tb * 16 + l15) * LT + lq * 8);
                    const bf16x8 rfr = *(const bf16x8*)(NcrT + (j * SL + tb * 16 + l15) * LT + lq * 8);
                    acc = MFMA16(af, bfr, acc); yacc = MFMA16(af, rfr, yacc); }
#pragma unroll
                for (int r = 0; r < 4; ++r) RHS[(vb * 16 + lq * 4 + r) * 36 + (l15 & 3) * 8 + tb * 4 + (l15 >> 2)] = acc[r];
                if (rep6 == 0) {
#pragma unroll
                    for (int q = 0; q < 2; ++q) { const int kr = kb * 16 + l15, vr = (vb0 + q) * 16 + l15;
                        const bf16x8 cf = *(const bf16x8*)(CmT + j * TSJ + TROW(kr) + TBLK(kr, lq)), vf = *(const bf16x8*)(VmT + j * TSJ + TROW(vr) + TBLK(vr, lq));
                        ST[q] = MFMA16(cf, vf, ST[q]); } }
            }
            LDS_BAR();
            for (int rep4 = 0; rep4 < REP_RW_ST3; ++rep4)
            if (wid < 4)
            {
                const int v3 = tid >> 2, q3 = tid & 3;
                const f32x4 r0 = *(const f32x4*)(RHS + v3 * 36 + q3 * 8), r1 = *(const f32x4*)(RHS + v3 * 36 + q3 * 8 + 4);
                float x[8] = {r0[0], r0[1], r0[2], r0[3], r1[0], r1[1], r1[2], r1[3]};
                const float* cq = NbaT + (j * SL) * 36 + q3 * 8;
                f32x4 c0[2][4], c1[2][4];
#define RW_LOADC(buf, g) do { _Pragma("unroll") for (int jj = 0; jj < 4; ++jj) { if ((g) < 4) c0[buf][jj] = *(const f32x4*)(cq + (4 * (g) + jj) * 36); c1[buf][jj] = *(const f32x4*)(cq + (4 * (g) + jj) * 36 + 4); } } while (0)
#define RW_PIVOT(jj) do { const float ub = DPP_QBCAST(x[g], jj); _Pragma("unroll") for (int i = (jj == 3 ? g + 1 : g); i < 8; ++i) x[i] = __builtin_fmaf(ub, i < 4 ? c0[g & 1][jj][i] : c1[g & 1][jj][i - 4], x[i]); } while (0)
                RW_LOADC(0, 0);
#pragma unroll
                for (int g = 0; g < 8; ++g) {
                    if (g + 1 < 8) RW_LOADC((g + 1) & 1, g + 1);
                    RW_PIVOT(0); RW_PIVOT(1); RW_PIVOT(2); RW_PIVOT(3);
                }
#undef RW_PIVOT
#undef RW_LOADC
                bf16_t* ud = Umat + v3 * LT + q3;
#pragma unroll
                for (int i = 0; i < 8; ++i) ud[4 * i] = f2bf(x[i]);
            }
            LDS_BAR();
            {
                const int vb = wid >> 1, tb = wid & 1;
                { const bf16x8 af = *(const bf16x8*)(Umat + (vb * 16 + l15) * LT + lq * 8), bfr = *(const bf16x8*)(NbrT + (j * SL + tb * 16 + l15) * LT + lq * 8); yacc = MFMA16(af, bfr, yacc); }
                { u32x2 w; w.x = pack_bf16(yacc[0], yacc[1]); w.y = pack_bf16(yacc[2], yacc[3]); if (j == 0) ypend0 = w; else ypend1 = w; }
#pragma unroll
                for (int q = 0; q < 2; ++q) {
                    const int kr = kb * 16 + l15;
                    const bf16x8 bf_ = *(const bf16x8*)(BmT + j * TSJ + TROW(kr) + TBLK(kr, lq)), uf = *(const bf16x8*)(Umat + ((vb0 + q) * 16 + l15) * LT + lq * 8);
                    ST[q] = MFMA16(bf_, uf, ST[q]);
                    const f32x4 wl = *(const f32x4*)(WL + j * 64 + kb * 16 + lq * 4);
                    ST[q] = ST[q] * wl;
                    if (j == 0) { u32x2 w; w.x = pack_bf16(ST[q][0], ST[q][1]); w.y = pack_bf16(ST[q][2], ST[q][3]); *(u32x2*)(Sb + ((vb0 + q) * 16 + l15) * LP + kb * 16 + lq * 4) = w; } }
            }
        }
    }
    RW_STORE_Y(NC_ALL - 1);
#undef RW_STORE_Y
}

__device__ __forceinline__ void mlstm_job(const Params& p, int job, unsigned char* smem) {
    bf16_t* q_s = (bf16_t*)smem;
    bf16_t* k_s = q_s + 2 * 64 * LP; bf16_t* kwT = k_s + 64 * LP; bf16_t* vT = kwT + 64 * LP;
    bf16_t* st = vT + 2 * 80 * LP; bf16_t* CT = st + 64 * LP;
    float* den_s = (float*)(CT + 80 * LP); float* G = den_s + 64;
    constexpr int GSZ = 384, G_A = 0, G_M = 64, G_INTER = 128, G_FLO = 192, G_WTS = 256, G_DECAY = 320;
    static_assert((2 * 64 + 64 + 64 + 2 * 80 + 64 + 80) * LP * 2 + (64 + 4 * GSZ) * 4 <= LDS_BYTES - 16, "mlstm LDS");
    const bf16_t* U = (const bf16_t*)(p.ws + WS_U);
    int tid = threadIdx.x; OPAQUE(tid);
    const int lane = tid & 63, wid = RFL(tid >> 6), l15 = lane & 15, lq = lane >> 4;
    const int z = job / H_M, h = job % H_M, d = z / BATCH, b = z % BATCH;
    const int hc0 = h * 64;
    const bf16_t* Ptb = (const bf16_t*)(p.ws + WS_PT) + (size_t)b * T_ALL * P2_LD; const int tokb = b * T_ALL;
    bf16_t* Pcw = (bf16_t*)(p.ws + WS_PC); const int hcol = (d ? OFF_MK : OFF_MQ) + hc0;
    __syncthreads();
    for (int idx = tid; idx < 80 * LP; idx += NTHREADS) { CT[idx] = 0; if (idx >= 64 * LP) { const bf16_t o1 = (idx < 65 * LP) ? (bf16_t)0x3f80 : (bf16_t)0; vT[idx] = o1; vT[80 * LP + idx] = o1; } }
    const float bi = p.m_bias_i[d * H_M + h], bfg = p.m_bias_f[d * H_M + h];
    const int pi = tid >> 3, cg = tid & 7, c0 = cg * 8;
    const int pp = d ? 63 - pi : pi, ppsw = (((pp >> 3) ^ cg) << 3) + (pp & 7);
    const int pb = wid & 3, half = wid >> 2, NE = half ? 3 : 2, eb0 = half ? 2 : 0;
    const int pr = pb * 16 + l15;
    f32x4 cacc[3];
#pragma unroll
    for (int k = 0; k < 3; ++k) cacc[k] = (f32x4){0.f, 0.f, 0.f, 0.f};
    float m_run = 0.f;
    u32x4 n_q, n_k, n_v; bf16_t n_gi = 0, n_gf = 0;
#define ML_PREFETCH(cn) do { const int _t0 = chunk_t0(d, (cn)); \
        n_q = *(const u32x4*)(U + pc_off(OFF_MQ + hc0 + c0, tokb + _t0 + pi)); n_k = *(const u32x4*)(U + pc_off(OFF_MK + hc0 + c0, tokb + _t0 + pi)); n_v = *(const u32x4*)(Ptb + (size_t)(_t0 + pi) * P2_LD + T_MV + hc0 + c0); \
        if (tid < 64) { const int _i2 = d ? 63 - tid : tid; const bf16_t* _gt = Ptb + (size_t)(_t0 + _i2) * P2_LD + T_GATES; n_gi = _gt[(2 * d) * H_M + h]; n_gf = _gt[(2 * d + 1) * H_M + h]; } } while (0)
    float kval[8], yv[3][4]; f32x4 sacc[2], num[3];
#define ML_T1(cc) do { bf16_t* _qb = q_s + ((cc) & 1) * 64 * LP; bf16_t* _vt = vT + ((cc) & 1) * 80 * LP + c0 * LP + ppsw; const u32x4 _q = n_q, _k = n_k, _v = n_v; \
        *(u32x4*)(_qb + pp * LP + c0) = _q; *(u32x4*)(k_s + pp * LP + c0) = _k; unpack8(_k, kval); \
        _vt[0 * LP] = (bf16_t)(_v.x & 0xffff); _vt[1 * LP] = (bf16_t)(_v.x >> 16); _vt[2 * LP] = (bf16_t)(_v.y & 0xffff); _vt[3 * LP] = (bf16_t)(_v.y >> 16); \
        _vt[4 * LP] = (bf16_t)(_v.z & 0xffff); _vt[5 * LP] = (bf16_t)(_v.z >> 16); _vt[6 * LP] = (bf16_t)(_v.w & 0xffff); _vt[7 * LP] = (bf16_t)(_v.w >> 16); \
        if (wid == 0) { float* _g = G + ((cc) & 3) * GSZ; const float _li = bf2f(n_gi) + bi, _lf = logsigmoidf_(bf2f(n_gf) + bfg); \
            const float _bs = wave_scan_add(_lf); const float _av = _li - _bs; const float _A = wave_scan_max(_av); \
            const float _M = fmaxf(m_run, _A); const float _M63 = __shfl(_M, 63), _b63 = __shfl(_bs, 63); \
            _g[G_A + lane] = _av; _g[G_M + lane] = _M; _g[G_INTER + lane] = fexp(m_run - _M); _g[G_FLO + lane] = fexp(-(_bs + _M)); _g[G_WTS + lane] = fexp(_av - _M63); \
            if (lane == 0) _g[G_DECAY] = fexp(m_run - _M63); \
            m_run = _b63 + _M63; } } while (0)
#define ML_T2(cc) do { const bf16_t* _qb = q_s + ((cc) & 1) * 64 * LP; _Pragma("unroll") for (int j = 0; j < 2; ++j) { sacc[j] = (f32x4){0.f, 0.f, 0.f, 0.f}; const int sb = 2 * half + j; \
        if (sb <= pb) { _Pragma("unroll") for (int kk = 0; kk < 2; ++kk) { const bf16x8 af = *(const bf16x8*)(_qb + (pb * 16 + l15) * LP + kk * 32 + lq * 8), bfr = *(const bf16x8*)(k_s + (sb * 16 + l15) * LP + kk * 32 + lq * 8); \
            sacc[j] = MFMA16(bfr, af, sacc[j]); } } } } while (0)
#define ML_T3(cc) do { const float* _g = G + ((cc) & 3) * GSZ; const float Mp = _g[G_M + pr]; \
        _Pragma("unroll") for (int j = 0; j < 2; ++j) { const int s0 = (2 * half + j) * 16 + lq * 4; const f32x4 as4 = *(const f32x4*)(_g + G_A + s0); float val[4]; \
            _Pragma("unroll") for (int r = 0; r < 4; ++r) { const float e = fexp(as4[r] - Mp); val[r] = (s0 + r <= pr) ? sacc[j][r] * e : 0.f; } \
            u32x2 w; w.x = pack_bf16(val[0], val[1]); w.y = pack_bf16(val[2], val[3]); *(u32x2*)(st + pr * LP + s0) = w; } \
        const float wt = _g[G_WTS + pp]; \
        _Pragma("unroll") for (int j = 0; j < 8; j += 2) { const unsigned w = pack_bf16(kval[j] * wt, kval[j + 1] * wt); kwT[(c0 + j) * LP + ppsw] = (bf16_t)(w & 0xffff); kwT[(c0 + j + 1) * LP + ppsw] = (bf16_t)(w >> 16); } } while (0)
#define ML_T4(cc) do { const float* _g = G + ((cc) & 3) * GSZ; const bf16_t* _qb = q_s + ((cc) & 1) * 64 * LP; const bf16_t* _vb = vT + ((cc) & 1) * 80 * LP; const float decay = _g[G_DECAY], ip = _g[G_INTER + pr]; \
        _Pragma("unroll") for (int k = 0; k < 3; ++k) { num[k] = (f32x4){0.f, 0.f, 0.f, 0.f}; \
            if (k < NE) { const int eb = eb0 + k; f32x4 a1 = (f32x4){0.f, 0.f, 0.f, 0.f}, a2 = (f32x4){0.f, 0.f, 0.f, 0.f}; \
                _Pragma("unroll") for (int kk = 0; kk < 2; ++kk) { const int vrow = eb * 16 + l15, krow = pb * 16 + l15; \
                    const bf16x8 qf = *(const bf16x8*)(_qb + (pb * 16 + l15) * LP + kk * 32 + lq * 8), cf = *(const bf16x8*)(CT + (eb * 16 + l15) * LP + kk * 32 + lq * 8); \
                    const bf16x8 sf = *(const bf16x8*)(st + (pb * 16 + l15) * LP + kk * 32 + lq * 8), vf = *(const bf16x8*)(_vb + vrow * LP + ((((kk * 4 + lq) ^ (vrow >> 3)) & 7) << 3)); \
                    const bf16x8 kf = *(const bf16x8*)(kwT + krow * LP + ((((kk * 4 + lq) ^ (krow >> 3)) & 7) << 3)); \
                    a1 = MFMA16(cf, qf, a1); a2 = MFMA16(vf, sf, a2); \
                    if (kk == 0) cacc[k] = cacc[k] * decay; \
                    cacc[k] = MFMA16(kf, vf, cacc[k]); } \
                _Pragma("unroll") for (int r = 0; r < 4; ++r) num[k][r] = ip * a1[r] + a2[r]; \
                if (eb == 4 && lq == 0) den_s[pr] = num[k][0]; } } } while (0)
#define ML_T5(cc) do { const float dinv = frcp(fmaxf(fabsf(den_s[pr]), G[((cc) & 3) * GSZ + G_FLO + pr])); \
        _Pragma("unroll") for (int k = 0; k < 3; ++k) if (k < NE) { const int eb = eb0 + k; \
            if (eb < 4) { _Pragma("unroll") for (int r = 0; r < 4; ++r) yv[k][r] = num[k][r] * dinv; } \
            u32x2 w; w.x = pack_bf16(cacc[k][0], cacc[k][1]); w.y = pack_bf16(cacc[k][2], cacc[k][3]); *(u32x2*)(CT + (eb * 16 + l15) * LP + pb * 16 + lq * 4) = w; } } while (0)
#define ML_STORE_Y(cc) do { const int _tt = chunk_t0(d, (cc)) + (d ? 63 - pr : pr); if (_tt >= CTX_LEN) { _Pragma("unroll") for (int k = 0; k < 3; ++k) if (k < NE && eb0 + k < 4) { \
            u32x2 _w; _w.x = pack_bf16(yv[k][0], yv[k][1]); _w.y = pack_bf16(yv[k][2], yv[k][3]); *(u32x2*)(Pcw + pc_off(hcol + (eb0 + k) * 16 + lq * 4, tokb + _tt)) = _w; } } } while (0)
    ML_PREFETCH(0);
    ML_T1(0); ML_PREFETCH(1 < NC_ALL ? 1 : 0);
    LDS_BAR();
    ML_T2(0);
    LDS_BAR();
    ML_T3(0); ML_T1(1); ML_PREFETCH(2 < NC_ALL ? 2 : NC_ALL - 1);
    LDS_BAR();
    for (int c = 0; c < NC_ALL; ++c) {
        ML_T4(c); ML_T2(c + 1);
        LDS_BAR();
        ML_T5(c); ML_T3(c + 1); ML_T1(c + 2);
        ML_STORE_Y(c);
        ML_PREFETCH(c + 3 < NC_ALL ? c + 3 : NC_ALL - 1);
        LDS_BAR();
    }
#undef ML_PREFETCH
#undef ML_T1
#undef ML_T2
#undef ML_T3
#undef ML_T4
#undef ML_T5
#undef ML_STORE_Y
}

static_assert(W_M == W_R, "combine lane mapping assumes equal head groups");
__device__ __forceinline__ void phase_combine(const Params& p, int row_lo, int row_hi, int row_step, bool dry) {
    int tid = threadIdx.x; OPAQUE(tid); const int lane = tid & 63, wid = tid >> 6;
    bf16_t* Pc = (bf16_t*)(p.ws + WS_PC); bf16_t* Pt = (bf16_t*)(p.ws + WS_PT);
    constexpr int NPASS = W_M / 512 > 0 ? W_M / 512 : 1;
    constexpr int LANES_USED = W_M >= 512 ? 64 : W_M / 8;
    static_assert(NPASS == 1, "combine keeps one pass of per-lane constants and one row of prefetch in registers");
    const bool act = lane < LANES_USED; const int ch = lane * 8, chc = act ? ch : 0;
    const f32x4 nw0 = *(const f32x4*)(p.m_norm_w + chc), nw1 = *(const f32x4*)(p.m_norm_w + chc + 4);
    const f32x4 rw0 = *(const f32x4*)(p.r_norm_w + chc), rw1 = *(const f32x4*)(p.r_norm_w + chc + 4), rb0 = *(const f32x4*)(p.r_norm_b + chc), rb1 = *(const f32x4*)(p.r_norm_b + chc + 4);
    u32x4 n_hf, n_hb, n_mo, n_yf, n_yb, n_ybn, n_gg;
#define CB_LOAD(r) do { const int _b = (r) / SEQ, _tok = _b * T_ALL + CTX_LEN + (r) % SEQ; const bf16_t* _pr = Pt + (size_t)_tok * P2_LD; \
        n_hf = *(const u32x4*)(Pc + pc_off(OFF_MQ + chc, _tok)); n_hb = *(const u32x4*)(Pc + pc_off(OFF_MK + chc, _tok)); n_mo = *(const u32x4*)(_pr + T_MO + chc); \
        n_yf = *(const u32x4*)(Pc + pc_off(OFF_RR + chc, _tok)); n_yb = *(const u32x4*)(Pc + pc_off(OFF_RK + chc, _tok)); n_ybn = *(const u32x4*)(Pc + pc_off(OFF_RV + chc, _tok)); n_gg = *(const u32x4*)(_pr + T_MV + chc); } while (0)
    if (row_lo + wid < row_hi) CB_LOAD(row_lo + wid);
    for (int row = row_lo + wid; row < row_hi; row += row_step) {
        const int b = row / SEQ, l = row % SEQ;
        const int tok = b * T_ALL + CTX_LEN + l; bf16_t* prow = Pt + (size_t)tok * P2_LD;
        const u32x4 hf = n_hf, hb = n_hb, mo = n_mo, yf = n_yf, yb = n_yb, ybn = n_ybn, gg = n_gg;
        { const int nr = row + row_step; CB_LOAD(nr < row_hi ? nr : row); }
        float a[8], c[8], e[8], sM[8], sR[8];
        unpack8(hf, a); unpack8(hb, c); float sum = 0.f;
#pragma unroll
        for (int j = 0; j < 8; ++j) { sM[j] = a[j] + c[j]; sum += sM[j]; }
        float mu = red8(sum) * (1.0f / 64.0f), q = 0.f;
#pragma unroll
        for (int j = 0; j < 8; ++j) { sM[j] -= mu; q += sM[j] * sM[j]; }
        float rstd = rsqrtf(red8(q) * (1.0f / 64.0f) + LN_EPS);
        unpack8(mo, e);
        float oM[8];
#pragma unroll
        for (int j = 0; j < 8; ++j) oM[j] = sM[j] * rstd * (j < 4 ? nw0[j] : nw1[j - 4]) * sigmoidf_(e[j]);
        unpack8(yf, a); unpack8(yb, c); sum = 0.f;
#pragma unroll
        for (int j = 0; j < 8; ++j) { sR[j] = a[j] + c[j]; sum += sR[j]; }
        mu = red8(sum) * (1.0f / 64.0f); q = 0.f;
#pragma unroll
        for (int j = 0; j < 8; ++j) { sR[j] -= mu; q += sR[j] * sR[j]; }
        rstd = rsqrtf(red8(q) * (1.0f / 64.0f) + GN_EPS);
        unpack8(ybn, a); unpack8(gg, c);
        float oR[8];
#pragma unroll
        for (int j = 0; j < 8; ++j) oR[j] = (sR[j] * rstd * (j < 4 ? rw0[j] : rw1[j - 4]) + (j < 4 ? rb0[j] : rb1[j - 4]) + a[j]) * c[j];
        if (act) { u32x4 w; w.x = pack_bf16(oM[0], oM[1]); w.y = pack_bf16(oM[2], oM[3]); w.z = pack_bf16(oM[4], oM[5]); w.w = pack_bf16(oM[6], oM[7]);
            bf16_t* orow = dry ? (bf16_t*)(p.ws + WS_U) + (size_t)row * MIX_W : prow;
            *(u32x4*)(orow + ch) = w;
            w.x = pack_bf16(oR[0], oR[1]); w.y = pack_bf16(oR[2], oR[3]); w.z = pack_bf16(oR[4], oR[5]); w.w = pack_bf16(oR[6], oR[7]);
            *(u32x4*)(orow + W_M + ch) = w; }
    }
#undef CB_LOAD
}

__device__ __forceinline__ void phase_ln1_router(const Params& p, unsigned char* smem, int tile) {
    constexpr int TOK_LD = D_MODEL + 4;
    float* tok = (float*)smem;
    float* pe = tok + 16 * TOK_LD;
    float* pg = pe + 16 * NWAVES * 32;
    float* logit = pg + 16 * NWAVES * 4;
    int* hist = (int*)(logit + 16 * 40);
    float* cvec = (float*)(hist + 32);
    int tid = threadIdx.x; OPAQUE(tid); const int lane = tid & 63, wid = tid >> 6, G = gridDim.x;
    const float* mod = (const float*)(p.ws + WS_MOD); const bf16_t* o = (const bf16_t*)(p.ws + WS_O);
    bf16_t* xm = (bf16_t*)(p.ws + WS_XM); bf16_t* x1 = (bf16_t*)(p.ws + WS_X1); int* eidx = (int*)(p.ws + WS_EIDX); float* ewt = (float*)(p.ws + WS_EWT); int* ccnt = (int*)(p.ws + WS_CCNT);
    constexpr int RKS = D_MODEL / (NWAVES * 32), NTE = (N_EXPERTS + 15) / 16;
    static_assert(D_MODEL % (NWAVES * 32) == 0 && N_EXPERTS <= 32 && N_GROUPS <= 4, "router tiling");
    const int l15 = lane & 15, lq = lane >> 4;
    bf16x8 wh[NTE + 1][RKS], wl[NTE + 1][RKS];
#pragma unroll
    for (int nt = 0; nt <= NTE; ++nt)
#pragma unroll
        for (int ks = 0; ks < RKS; ++ks) { float wv[8];
#pragma unroll
            for (int j = 0; j < 8; ++j) { const int k = wid * (RKS * 32) + ks * 32 + lq * 8 + j;
                if (nt < NTE) { const int e = nt * 16 + l15; wv[j] = (e < N_EXPERTS) ? p.rt_e[(size_t)k * N_EXPERTS + (e < N_EXPERTS ? e : 0)] : 0.f; }
                else wv[j] = (l15 < N_GROUPS) ? p.rt_g[(size_t)k * N_GROUPS + (l15 < N_GROUPS ? l15 : 0)] : 0.f; }
            split8(wv, wh[nt][ks], wl[nt][ks]); }
    if (tile == 0) for (int k = tid; k < D_MODEL; k += NTHREADS) xm[(size_t)NLAT * D_MODEL + k] = 0;
    __syncthreads();
    if (tid < 32) hist[tid] = 0;
    (void)G;
    {   const float* mt = mod + (size_t)((tile * 256) / SEQ) * 6 * D_MODEL;
        for (int k = tid; k < D_MODEL; k += NTHREADS) { cvec[k] = mt[2 * D_MODEL + k]; cvec[D_MODEL + k] = p.ln1_g[k]; cvec[2 * D_MODEL + k] = p.ln1_b[k]; cvec[3 * D_MODEL + k] = mt[4 * D_MODEL + k] + 1.0f; cvec[4 * D_MODEL + k] = mt[3 * D_MODEL + k]; } }
    for (int it = 0; it < 256 / 16; ++it) {
        const int rbase = tile * 256 + it * 16;
        LDS_BAR();
        {
            const int lr0 = wid * 2, row0 = rbase + lr0, b = row0 / SEQ;
            const float* m = mod + (size_t)b * 6 * D_MODEL;
            f32x4 v[2][NV4]; float s[2] = {0.f, 0.f};
#pragma unroll
            for (int rr = 0; rr < 2; ++rr)
#pragma unroll
                for (int i = 0; i < NV4; ++i) { const int k = 4 * lane + 256 * i; const size_t ro = (size_t)(row0 + rr) * D_MODEL + k;
                    const u32x2 ob = *(const u32x2*)(o + ro); const f32x4 ov = (f32x4){bf2f((bf16_t)(ob.x & 0xffff)), bf2f((bf16_t)(ob.x >> 16)), bf2f((bf16_t)(ob.y & 0xffff)), bf2f((bf16_t)(ob.y >> 16))};
                    const f32x4 xv = *(const f32x4*)(p.x + ro), g1 = *(const f32x4*)(cvec + k);
                    v[rr][i] = xv * ALPHA + g1 * ov; s[rr] += (v[rr][i][0] + v[rr][i][1]) + (v[rr][i][2] + v[rr][i][3]); }
            float mu[2], rstd[2], q[2];
#pragma unroll
            for (int rr = 0; rr < 2; ++rr) mu[rr] = wave_sum(s[rr]) * (1.0f / D_MODEL);
#pragma unroll
            for (int rr = 0; rr < 2; ++rr) { q[rr] = 0.f;
#pragma unroll
                for (int i = 0; i < NV4; ++i) { const f32x4 dd = v[rr][i] - mu[rr]; q[rr] += (dd[0] * dd[0] + dd[1] * dd[1]) + (dd[2] * dd[2] + dd[3] * dd[3]); } }
#pragma unroll
            for (int rr = 0; rr < 2; ++rr) rstd[rr] = rsqrtf(wave_sum(q[rr]) * (1.0f / D_MODEL) + LN_EPS);
#pragma unroll
            for (int rr = 0; rr < 2; ++rr) { s[rr] = 0.f;
#pragma unroll
                for (int i = 0; i < NV4; ++i) { const int k = 4 * lane + 256 * i; v[rr][i] = (v[rr][i] - mu[rr]) * rstd[rr] * *(const f32x4*)(cvec + D_MODEL + k) + *(const f32x4*)(cvec + 2 * D_MODEL + k);
                    { u32x2 w; w.x = pack_bf16(v[rr][i][0], v[rr][i][1]); w.y = pack_bf16(v[rr][i][2], v[rr][i][3]); *(u32x2*)(x1 + (size_t)(row0 + rr) * D_MODEL + k) = w; }
                    s[rr] += (v[rr][i][0] + v[rr][i][1]) + (v[rr][i][2] + v[rr][i][3]); } }
#pragma unroll
            for (int rr = 0; rr < 2; ++rr) mu[rr] = wave_sum(s[rr]) * (1.0f / D_MODEL);
#pragma unroll
            for (int rr = 0; rr < 2; ++rr) { q[rr] = 0.f;
#pragma unroll
                for (int i = 0; i < NV4; ++i) { const f32x4 dd = v[rr][i] - mu[rr]; q[rr] += (dd[0] * dd[0] + dd[1] * dd[1]) + (dd[2] * dd[2] + dd[3] * dd[3]); } }
#pragma unroll
            for (int rr = 0; rr < 2; ++rr) rstd[rr] = rsqrtf(wave_sum(q[rr]) * (1.0f / D_MODEL) + LN_EPS);
#pragma unroll
            for (int rr = 0; rr < 2; ++rr)
#pragma unroll
                for (int i = 0; i < NV4; ++i) { const int k = 4 * lane + 256 * i; const f32x4 tv = (v[rr][i] - mu[rr]) * rstd[rr] * *(const f32x4*)(cvec + 3 * D_MODEL + k) + *(const f32x4*)(cvec + 4 * D_MODEL + k);
                    *(f32x4*)(tok + (lr0 + rr) * TOK_LD + k) = tv; u32x2 w; w.x = pack_bf16(tv[0], tv[1]); w.y = pack_bf16(tv[2], tv[3]); *(u32x2*)(xm + (size_t)(row0 + rr) * D_MODEL + k) = w; }
        }
        LDS_BAR();
        {
            f32x4 racc[NTE + 1];
#pragma unroll
            for (int nt = 0; nt <= NTE; ++nt) racc[nt] = (f32x4){0.f, 0.f, 0.f, 0.f};
#pragma unroll
            for (int ks = 0; ks < RKS; ++ks) { const float* tp = tok + l15 * TOK_LD + wid * (RKS * 32) + ks * 32 + lq * 8;
                const f32x4 t0 = *(const f32x4*)tp, t1 = *(const f32x4*)(tp + 4); const float xv[8] = {t0[0], t0[1], t0[2], t0[3], t1[0], t1[1], t1[2], t1[3]};
                bf16x8 ah, al; split8(xv, ah, al);
#pragma unroll
                for (int nt = 0; nt <= NTE; ++nt) { racc[nt] = MFMA16(al, wh[nt][ks], racc[nt]); racc[nt] = MFMA16(ah, wl[nt][ks], racc[nt]); racc[nt] = MFMA16(ah, wh[nt][ks], racc[nt]); } }
#pragma unroll
            for (int r = 0; r < 4; ++r) {
#pragma unroll
                for (int nt = 0; nt < NTE; ++nt) pe[((4 * lq + r) * NWAVES + wid) * 32 + nt * 16 + l15] = racc[nt][r];
                if (l15 < 4) pg[((4 * lq + r) * NWAVES + wid) * 4 + l15] = racc[NTE][r]; }
        }
        LDS_BAR();
        {   const int r = tid >> 5, e = tid & 31; float acc = 0.f, accg = 0.f;
#pragma unroll
            for (int w = 0; w < NWAVES; ++w) { acc += pe[(r * NWAVES + w) * 32 + e]; if (e < 4) accg += pg[(r * NWAVES + w) * 4 + e]; }
            if (e < N_EXPERTS) logit[r * 40 + 4 + e] = acc + p.rt_e_b[e];
            if (e < N_GROUPS) logit[r * 40 + e] = accg + p.rt_g_b[e]; }
        LDS_BAR();
        if (tid < 16) {
            const float* lgt = logit + tid * 40; const int row = rbase + tid;
            int grp = 0; float mx = lgt[0];
            for (int gI = 1; gI < N_GROUPS; ++gI) if (lgt[gI] > mx) { mx = lgt[gI]; grp = gI; }
            float se = 0.f; for (int gI = 0; gI < N_GROUPS; ++gI) se += fexp(lgt[gI] - mx);
            const float p_top = 1.0f / se;
            const float* le = lgt + 4 + grp * E_PER_GROUP;
            int i0 = 0; for (int e = 1; e < E_PER_GROUP; ++e) if (le[e] > le[i0]) i0 = e;
            int i1 = (i0 == 0) ? 1 : 0; for (int e = 0; e < E_PER_GROUP; ++e) if (e != i0 && le[e] > le[i1]) i1 = e;
            const float e1 = fexp(le[i1] - le[i0]); const float w0 = 1.0f / (1.0f + e1), w1 = e1 / (1.0f + e1);
            const int ea = grp * E_PER_GROUP + i0, eb = grp * E_PER_GROUP + i1;
            eidx[2 * row] = ea; eidx[2 * row + 1] = eb; ewt[2 * row] = w0 * p_top; ewt[2 * row + 1] = w1 * p_top;
            atomicAdd(&hist[ea], 1); atomicAdd(&hist[eb], 1);
        }
    }
    __syncthreads();
    if (tid < N_EXPERTS) ccnt[tile * N_EXPERTS + tid] = hist[tid];
}

__device__ __forceinline__ void phase_route(const Params& p, unsigned char* smem) {
    int* tot = (int*)smem; int* pre = tot + 32; int* pstart = pre + 32; int* pend = pstart + 32; int* coff = pend + 32; int* run = coff + 32; int* wcnt = run + 32; int* psum = wcnt + NWAVES * 32; int* ppre = psum + 16 * 32;
    int tid = threadIdx.x; OPAQUE(tid); const int lane = tid & 63, wid = tid >> 6; const int G = gridDim.x;
    constexpr int NT = NLAT / 256, NP = 512;
    const int* eidx = (const int*)(p.ws + WS_EIDX); const float* ewt = (const float*)(p.ws + WS_EWT); const int* ccnt = (const int*)(p.ws + WS_CCNT);
    int* dest = (int*)(p.ws + WS_DEST); int* tokbuf = (int*)(p.ws + WS_TOKBUF); float* wbuf = (float*)(p.ws + WS_WBUF); int* blk_exp = (int*)(p.ws + WS_BLKEXP);
    const unsigned long long lt = (1ull << lane) - 1ull;
    for (int tile = blockIdx.x; tile < NT; tile += G) {
        __syncthreads();
        {
            constexpr int TPP = (NT + 15) / 16; const int e = tid & 31, part = tid >> 5; int sp = 0, pp2 = 0;
            if (e < N_EXPERTS) {
#pragma unroll 4
                for (int q = 0; q < TPP; ++q) { const int bb = part * TPP + q; const int cval = (bb < NT) ? ccnt[(bb < NT ? bb : 0) * N_EXPERTS + e] : 0; if (bb < tile) pp2 += cval; sp += cval; } }
            psum[part * 32 + e] = sp; ppre[part * 32 + e] = pp2;
        }
        __syncthreads();
        if (tid < N_EXPERTS) { int s2 = 0, pr = 0;
#pragma unroll
            for (int q = 0; q < 16; ++q) { s2 += psum[q * 32 + tid]; pr += ppre[q * 32 + tid]; }
            tot[tid] = s2; pre[tid] = pr; run[tid] = 0; }
        __syncthreads();
        if (tid == 0) { int s = 0; for (int e = 0; e < N_EXPERTS; ++e) { pstart[e] = s; s += (tot[e] + MOE_BLOCK - 1) / MOE_BLOCK * MOE_BLOCK; pend[e] = s; } }
        __syncthreads();
        if (tid < N_EXPERTS) coff[tid] = pstart[tid] + pre[tid];
        for (int base = 0; base < NP; base += NTHREADS) {
            const int i = base + tid; const bool valid = i < NP; const int pidx = tile * NP + (valid ? i : 0);
            const int e = valid ? eidx[pidx] : -1; int rk = 0;
            for (int ex = 0; ex < N_EXPERTS; ++ex) { const unsigned long long mk = BALLOT(e == ex); if (e == ex) rk = (int)POPCLL(mk & lt); if (lane == 0) wcnt[wid * 32 + ex] = (int)POPCLL(mk); }
            __syncthreads();
            if (valid) { int off = coff[e] + run[e]; for (int w = 0; w < wid; ++w) off += wcnt[w * 32 + e];
                const int dst = off + rk; dest[pidx] = dst; tokbuf[dst] = pidx >> 1; wbuf[dst] = ewt[pidx]; }
            __syncthreads();
            if (tid < N_EXPERTS) { int a2 = 0; for (int w = 0; w < NWAVES; ++w) a2 += wcnt[w * 32 + tid]; run[tid] += a2; }
            __syncthreads();
        }
        if (tile == 0) {
            for (int rb = tid; rb < MAX_RB; rb += NTHREADS) { int e = 0; while (e < N_EXPERTS - 1 && rb * MOE_BLOCK >= pend[e]) ++e; blk_exp[rb] = e; }
            if (tid == 0) blk_exp[MAX_RB] = pend[N_EXPERTS - 1];
        }
        for (int e = tile; e < N_EXPERTS; e += NT) for (int r = pstart[e] + tot[e] + tid; r < pend[e]; r += NTHREADS) { tokbuf[r] = NLAT; wbuf[r] = 0.f; }
    }
}

__device__ __forceinline__ void phase_final(const Params& p, bool dry) {
    int tid = threadIdx.x; OPAQUE(tid); const int lane = tid & 63, wid = tid >> 6;
    const float* mod = (const float*)(p.ws + WS_MOD); const bf16_t* ypair = (const bf16_t*)(p.ws + WS_YPAIR); const int* dest = (const int*)(p.ws + WS_DEST); const bf16_t* x1 = (const bf16_t*)(p.ws + WS_X1);
    float* ob = dry ? (float*)(p.ws + WS_HID) : p.out;
    const int stride = gridDim.x * NWAVES;
    int dn[2][2];
#define FN_DEST(ra) do { _Pragma("unroll") for (int rr = 0; rr < 2; ++rr) { const int _r = ((ra) + rr * stride < NLAT) ? (ra) + rr * stride : ((ra) < NLAT ? (ra) : 0); dn[rr][0] = dest[2 * _r]; dn[rr][1] = dest[2 * _r + 1]; } } while (0)
    FN_DEST(blockIdx.x * NWAVES + wid);
    for (int rowa = blockIdx.x * NWAVES + wid; rowa < NLAT; rowa += 2 * stride) {
        f32x4 v[2][NV4]; float s[2] = {0.f, 0.f}; int rows[2]; bool ok[2];
        const int dc[2][2] = {{dn[0][0], dn[0][1]}, {dn[1][0], dn[1][1]}};
        FN_DEST(rowa + 2 * stride);
#pragma unroll
        for (int rr = 0; rr < 2; ++rr) { rows[rr] = rowa + rr * stride; ok[rr] = rows[rr] < NLAT; const int row = ok[rr] ? rows[rr] : rowa;
            const int b = row / SEQ; const float* m = mod + (size_t)b * 6 * D_MODEL;
            const int p0 = dc[rr][0], p1 = dc[rr][1];
#pragma unroll
            for (int i = 0; i < NV4; ++i) { const int k = 4 * lane + 256 * i;
                const u32x2 ya = *(const u32x2*)(ypair + (size_t)p0 * D_MODEL + k), yb = *(const u32x2*)(ypair + (size_t)p1 * D_MODEL + k);
                f32x4 f; f[0] = bf2f((bf16_t)(ya.x & 0xffff)) + bf2f((bf16_t)(yb.x & 0xffff)); f[1] = bf2f((bf16_t)(ya.x >> 16)) + bf2f((bf16_t)(yb.x >> 16));
                f[2] = bf2f((bf16_t)(ya.y & 0xffff)) + bf2f((bf16_t)(yb.y & 0xffff)); f[3] = bf2f((bf16_t)(ya.y >> 16)) + bf2f((bf16_t)(yb.y >> 16));
                const u32x2 xb = *(const u32x2*)(x1 + (size_t)row * D_MODEL + k); const f32x4 x1v = (f32x4){bf2f((bf16_t)(xb.x & 0xffff)), bf2f((bf16_t)(xb.x >> 16)), bf2f((bf16_t)(xb.y & 0xffff)), bf2f((bf16_t)(xb.y >> 16))};
                v[rr][i] = x1v * ALPHA + *(const f32x4*)(m + 5 * D_MODEL + k) * f; s[rr] += (v[rr][i][0] + v[rr][i][1]) + (v[rr][i][2] + v[rr][i][3]); } }
        float mu[2], q[2], rstd[2];
#pragma unroll
        for (int rr = 0; rr < 2; ++rr) mu[rr] = wave_sum(s[rr]) * (1.0f / D_MODEL);
#pragma unroll
        for (int rr = 0; rr < 2; ++rr) { q[rr] = 0.f;
#pragma unroll
            for (int i = 0; i < NV4; ++i) { const f32x4 dd = v[rr][i] - mu[rr]; q[rr] += (dd[0] * dd[0] + dd[1] * dd[1]) + (dd[2] * dd[2] + dd[3] * dd[3]); } }
#pragma unroll
        for (int rr = 0; rr < 2; ++rr) rstd[rr] = rsqrtf(wave_sum(q[rr]) * (1.0f / D_MODEL) + LN_EPS);
#pragma unroll
        for (int rr = 0; rr < 2; ++rr) if (ok[rr]) {
#pragma unroll
            for (int i = 0; i < NV4; ++i) { const int k = 4 * lane + 256 * i; *(f32x4*)(ob + (size_t)rows[rr] * D_MODEL + k) = (v[rr][i] - mu[rr]) * rstd[rr] * *(const f32x4*)(p.ln2_g + k) + *(const f32x4*)(p.ln2_b + k); } }
    }
#undef FN_DEST
}

__global__ void __launch_bounds__(NTHREADS, 2) k_mega(Params p) {
    DYN_SMEM(smem);
    LAS unsigned char* lds = (LAS unsigned char*)smem;
    const int G = gridDim.x;
    bf16_t* Pt = (bf16_t*)(p.ws + WS_PT);
#ifndef HIP_EMU
    volatile LAS unsigned* bst = (volatile LAS unsigned*)(lds + LDS_BYTES - 16);
    if (threadIdx.x == 0) { bst[0] = 0u; bst[1] = 0u; bst[2] = 0u; bst[3] = 0u; }
    __syncthreads();
    const XcdBarrier gbar = xcd_barrier_post((unsigned*)(p.ws + WS_BAR), bst);
#endif
    for (int rep = 0; rep < REP_PRO; ++rep) phase_prologue(p, smem);
    GRID_SYNC();
    for (int rep = 0; rep < REP_LNMOD; ++rep) phase_ln_mod(p);
    GRID_SYNC();
    for (int rep = 0; rep < REP_GEMM * REP_G1; ++rep)
    {   pg8::Gemm g{(const bf16_t*)(p.ws + WS_H), (const bf16_t*)(p.ws + WS_WIN), D_MODEL, D_MODEL, nullptr, nullptr, 0, 0, 0, 0};
        pg8::StaticOrder S; S.init(NTOK, IN_PAD, G, (int)blockIdx.x);
        pg8::EpiInProj E{(bf16_t*)(p.ws + WS_PC), Pt};
        pg8::gemm_phase<pg8::EpiInProj, pg8::StaticOrder, false>(lds, g, S, E); }
    GRID_SYNC();
    for (int rep = 0; rep < REP_CONV; ++rep) phase_conv(p, smem, rep > 0);
    GRID_SYNC();
    for (int rep = 0; rep < REP_RWKV; ++rep) for (int job = blockIdx.x; job < 2 * BATCH * H_R; job += G) rwkv_job(p, job, smem);
    for (int rep = 0; rep < REP_MLSTM; ++rep) for (int job = blockIdx.x; job < 2 * BATCH * H_M; job += G) mlstm_job(p, job, smem);
    GRID_SYNC();
    {   pg8::Gemm g{Pt + T_LWB, (const bf16_t*)(p.ws + WS_GBT), GK, P2_LD, nullptr, nullptr, 0, SEQ / 256, T_ALL, CTX_LEN};
        pg8::OwnTile S{(int)blockIdx.x, G, NLAT / 256, W_R / 256};
        pg8::EpiBf16Mapped E{{Pt + T_MV, P2_LD, W_R, nullptr}};
        pg8::gemm_phase<pg8::EpiBf16Mapped, pg8::OwnTile, false>(lds, g, S, E); }
    __syncthreads();
    for (int tile = blockIdx.x; tile < NLAT / 256; tile += G) phase_combine(p, tile * 256, tile * 256 + 256, NWAVES, false);
    __syncthreads();
    {   pg8::Gemm g{Pt, (const bf16_t*)(p.ws + WS_WOUT), MIX_W, P2_LD, nullptr, nullptr, 0, SEQ / 256, T_ALL, CTX_LEN};
        pg8::OwnTile S{(int)blockIdx.x, G, NLAT / 256, D_MODEL / 256};
        pg8::EpiBf16 E{(bf16_t*)(p.ws + WS_O), D_MODEL, D_MODEL, nullptr};
        pg8::gemm_phase<pg8::EpiBf16, pg8::OwnTile, false>(lds, g, S, E); }
    __syncthreads();
    for (int tile = blockIdx.x; tile < NLAT / 256; tile += G) { phase_ln1_router(p, smem, tile); __syncthreads(); }
    GRID_SYNC();
    for (int rep = 0; rep < REP_ROUTE; ++rep) phase_route(p, smem);
    GRID_SYNC();
    const int* blk_exp = (const int*)(p.ws + WS_BLKEXP);
    const int rows_total = blk_exp[MAX_RB];
    for (int rep = 0; rep < REP_GEMM * REP_G4; ++rep)
    {   pg8::Gemm g{(const bf16_t*)(p.ws + WS_XM), (const bf16_t*)(p.ws + WS_WGU), D_MODEL, D_MODEL, (const int*)(p.ws + WS_TOKBUF), blk_exp, (size_t)2 * D_EXPERT * D_MODEL, 0, 0, 0};
        pg8::StaticOrder S; S.init(rows_total, 2 * D_EXPERT, G, (int)blockIdx.x);
        pg8::EpiSwiGLU E{(bf16_t*)(p.ws + WS_HID), D_EXPERT};
        pg8::gemm_phase<pg8::EpiSwiGLU, pg8::StaticOrder, true>(lds, g, S, E); }
    GRID_SYNC();
    for (int rep = 0; rep < REP_GEMM * REP_G5; ++rep)
    {   pg8::Gemm g{(const bf16_t*)(p.ws + WS_HID), (const bf16_t*)(p.ws + WS_WDN), D_EXPERT, D_EXPERT, nullptr, blk_exp, (size_t)D_MODEL * D_EXPERT, 0, 0, 0};
        pg8::StaticOrder S; S.init(rows_total, D_MODEL, G, (int)blockIdx.x);
        pg8::EpiBf16 E{(bf16_t*)(p.ws + WS_YPAIR), D_MODEL, D_MODEL, (const float*)(p.ws + WS_WBUF)};
        pg8::gemm_phase<pg8::EpiBf16, pg8::StaticOrder, false>(lds, g, S, E); }
    GRID_SYNC();
    for (int rep = 0; rep < REP_FINAL; ++rep) phase_final(p, rep + 1 < REP_FINAL);
}

#ifdef HIP_EMU
void emu_dbg(const char* name, const void* p, int is_bf16, size_t n);
#define DBG(name, p, bf, n) emu_dbg(name, p, bf, n)
#else
#define DBG(name, p, bf, n)
#endif

extern "C" void kernel_launch(void* const* d_in, const int* in_sizes, int n_in, void* d_out, int out_size, void* d_ws, size_t ws_size, hipStream_t stream) {
    (void)in_sizes; (void)n_in; (void)out_size; (void)ws_size;
    Params p{};
    const float** dst = (const float**)&p;
    for (int i = 0; i < 33; ++i) dst[i] = (const float*)d_in[i];
    p.out = (float*)d_out; p.ws = (unsigned char*)d_ws;
    static int grid_blocks = 0;
    if (!grid_blocks) {
        int dev = 0, cus = 0, per_cu = 0;
        (void)hipGetDevice(&dev); (void)hipDeviceGetAttribute(&cus, hipDeviceAttributeMultiprocessorCount, dev);
#ifndef HIP_EMU
        (void)hipFuncSetAttribute((const void*)k_mega, hipFuncAttributeMaxDynamicSharedMemorySize, LDS_BYTES);
#endif
        (void)hipOccupancyMaxActiveBlocksPerMultiprocessor(&per_cu, k_mega, NTHREADS, (size_t)LDS_BYTES);
        if (per_cu < 1) per_cu = 1;
        int g = cus;
        if (g > MAX_GRID) g = MAX_GRID;
        while (g > 1 && (NLAT % (16 * g)) != 0) --g;
        grid_blocks = g;
    }
#ifdef HIP_EMU
    EMU_LAUNCH_COOP(k_mega, dim3(grid_blocks), dim3(NTHREADS), LDS_BYTES, stream, p);
    unsigned char* ws = p.ws;
    DBG("mod", ws + WS_MOD, 0, (size_t)(BATCH + 1) * 6 * D_MODEL); DBG("h", ws + WS_H, 1, (size_t)NTOK * D_MODEL);
    {   auto gather_c = [&](const char* name, int col, int width) { bf16_t* tmp = (bf16_t*)malloc((size_t)NLAT * width * 2);
            for (int b = 0; b < BATCH; ++b) for (int l = 0; l < SEQ; ++l) for (int c2 = 0; c2 < width; ++c2) tmp[((size_t)b * SEQ + l) * width + c2] = ((const bf16_t*)(ws + WS_PC))[pc_off(col + c2, b * T_ALL + CTX_LEN + l)];
            DBG(name, tmp, 1, (size_t)NLAT * width); free(tmp); };
        auto gather_t = [&](const char* name, int col, int width) { bf16_t* tmp = (bf16_t*)malloc((size_t)NLAT * width * 2);
            for (int b = 0; b < BATCH; ++b) for (int l = 0; l < SEQ; ++l) memcpy(tmp + ((size_t)b * SEQ + l) * width, (const bf16_t*)(ws + WS_PT) + ((size_t)b * T_ALL + CTX_LEN + l) * P2_LD + col, (size_t)width * 2);
            DBG(name, tmp, 1, (size_t)NLAT * width); free(tmp); };
        gather_c("Yf", OFF_RR, W_R); gather_c("Yb", OFF_RK, W_R); gather_c("Hf", OFF_MQ, W_M); gather_c("Hb", OFF_MK, W_M); gather_t("mixed", 0, MIX_W); }
#else
    (void)hipMemsetAsync(p.ws + WS_BAR, 0, (size_t)3456 * 4, stream);
    void* args[] = {&p};
    hipError_t e = hipLaunchCooperativeKernel((void*)k_mega, dim3(grid_blocks), dim3(NTHREADS), args, (size_t)LDS_BYTES, stream);
    if (e != hipSuccess) fprintf(stderr, "cooperative launch failed: %s (grid %d)\n", hipGetErrorString(e), grid_blocks);
#endif
}
```

```cpp
#ifndef HIP_EMU
#include <hip/hip_runtime.h>
#include <hip/hip_cooperative_groups.h>
#include <cstdio>
namespace cg = cooperative_groups;
#endif
#include <stdint.h>
#include <stddef.h>

#ifdef SMALL_CFG
constexpr int D_MODEL = 256, BATCH = 2, SEQ = 256, CTX_LEN = 128, H_M = 4, H_R = 4, N_GROUPS = 2, E_PER_GROUP = 4, D_EXPERT = 256;
#else
constexpr int D_MODEL = 1024, BATCH = 16, SEQ = 4096, CTX_LEN = 256, H_M = 8, H_R = 8, N_GROUPS = 4, E_PER_GROUP = 8, D_EXPERT = 512;
#endif
constexpr int GRID_W = 64, W_M = H_M * 64, W_R = H_R * 64, MIX_W = W_M + W_R, W_LORA = 64, A_LORA = 64, G_LORA = 128;
constexpr int CONV_CH = 2 * W_M + 3 * W_R;
constexpr int OFF_MQ = 0, OFF_MK = W_M, OFF_RR = 2 * W_M, OFF_RK = 2 * W_M + W_R, OFF_RV = 2 * W_M + 2 * W_R, OFF_MV = CONV_CH,
              OFF_MO = OFF_MV + W_M, OFF_GATES = OFF_MO + W_M, OFF_LWF = OFF_GATES + 4 * H_M, OFF_LWB = OFF_LWF + W_LORA,
              OFF_LA = OFF_LWB + W_LORA, OFF_LG = OFF_LA + A_LORA, IN_COLS = OFF_LG + G_LORA;
constexpr int IN_PAD = (IN_COLS + 255) / 256 * 256;
constexpr int P2_COLS = IN_COLS - CONV_CH, P2_LD = (P2_COLS + 63) / 64 * 64;
constexpr int T_MV = OFF_MV - CONV_CH, T_MO = OFF_MO - CONV_CH, T_GATES = OFF_GATES - CONV_CH, T_LWF = OFF_LWF - CONV_CH, T_LWB = OFF_LWB - CONV_CH, T_LA = OFF_LA - CONV_CH, T_LG = OFF_LG - CONV_CH;
static_assert(CONV_CH % 256 == 0 && T_MV == 0 && T_MO == W_M, "split-P layout");
constexpr int T_ALL = CTX_LEN + SEQ, NTOK = BATCH * T_ALL, NLAT = BATCH * SEQ, GRID_ROWS = SEQ / GRID_W;
constexpr int NC_CTX = CTX_LEN / 64, NC_ALL = T_ALL / 64;
__host__ __device__ __forceinline__ size_t pc_off(int col, int tok) { return ((size_t)(col >> 6) * NTOK + tok) * 64 + (col & 63); }
constexpr int N_EXPERTS = N_GROUPS * E_PER_GROUP, MOE_BLOCK = 256, N_PAIRS = 2 * NLAT, MAX_RB = N_PAIRS / MOE_BLOCK + N_EXPERTS,
              ROWS_P = MAX_RB * MOE_BLOCK;
constexpr int MAX_GRID = 1024;
constexpr float LOG2E = 1.4426950408889634f;
constexpr float ALPHA = 1.189207115002721f, DECAY_SCALE = 0.6065306597126334f, LN_EPS = 1e-6f, GN_EPS = 64e-5f;
constexpr int NTHREADS = 512, NWAVES = 8;
constexpr int REP_RWKV = 1, REP_MLSTM = 1, REP_GEMM = 1, REP_PRO = 1, REP_LNMOD = 1, REP_COMB = 1, REP_LN1 = 1, REP_ROUTE = 1, REP_CONV = 1, REP_RWSCAN = 1, REP_SYNC = 1, REP_FINAL = 1, REP_RW_S3 = 1, REP_RW_ST3 = 1, REP_RW_S1 = 1, REP_RW_MM = 1, REP_RW_S2 = 1, REP_RW_ST2 = 1, REP_G1 = 1, REP_G2 = 1, REP_G3 = 1, REP_G4 = 1, REP_G5 = 1;
constexpr int LDS_BYTES = 144 * 1024;
static_assert(N_EXPERTS <= 32 && N_GROUPS <= 4 && D_MODEL % 256 == 0 && IN_COLS % 8 == 0 && SEQ % 256 == 0, "shape assumptions");

typedef unsigned short bf16_t;
typedef short bf16x8 __attribute__((ext_vector_type(8)));
typedef short s16x4 __attribute__((ext_vector_type(4)));
typedef float f32x4 __attribute__((ext_vector_type(4)));
typedef float f32x2 __attribute__((ext_vector_type(2)));
typedef unsigned u32x4 __attribute__((ext_vector_type(4)));
typedef unsigned u32x2 __attribute__((ext_vector_type(2)));

#ifdef HIP_EMU
#define LAS
#define MFMA16(a, b, c) emu_mfma_16x16x32_bf16(a, b, c)
#define DYN_SMEM(name) unsigned char* name = emu_cur->blk->smem
#define GLDS16(g, l) emu_glds16((const void*)(g), (void*)(l))
#define S_BARRIER() __syncthreads()
#define WAIT_V(n)
#define WAIT_V_EPI(nst)
#define WAIT_L(n)
#define SETPRIO(x)
#define SCHED_BAR()
#define RFL(x) (x)
#define GRID_SYNC() emu_grid_sync()
#define GRID_SYNC_CG() emu_grid_sync()
#define LDS_BAR() __syncthreads()
#define WAVE_SYNC() emu_wave_sync()
#define OPAQUE_S(x)
#define OPAQUE(x)
#define BALLOT(p) emu_ballot(p)
#define POPCLL(x) __builtin_popcountll(x)
#define DPP_XOR1(v) emu_dpp_quad(v, 1, 0, 3, 2)
#define DPP_XOR2(v) emu_dpp_quad(v, 2, 3, 0, 1)
#define DPP_HMIRROR(v) emu_dpp_half_mirror(v)
#define DPP_QBCAST(v, j) emu_dpp_quad(v, j, j, j, j)
#define LDS_TR4(p) emu_ds_read_tr16_b64((const void*)(p))
#else
#define LAS __attribute__((address_space(3)))
#define MFMA16(a, b, c) __builtin_amdgcn_mfma_f32_16x16x32_bf16(a, b, c, 0, 0, 0)
#define DYN_SMEM(name) extern __shared__ __attribute__((aligned(16))) unsigned char name[]
#define GLDS16(g, l) __builtin_amdgcn_global_load_lds((const unsigned*)(g), (LAS unsigned*)(l), 16, 0, 0)
#define S_BARRIER() __builtin_amdgcn_s_barrier()
#define WAIT_V(n) asm volatile("s_waitcnt vmcnt(" #n ")" ::: "memory")
#define WAIT_V_EPI(nst) do { if ((nst) == 16) asm volatile("s_waitcnt vmcnt(24)" ::: "memory"); else if ((nst) == 32) asm volatile("s_waitcnt vmcnt(40)" ::: "memory"); else asm volatile("s_waitcnt vmcnt(6)" ::: "memory"); } while (0)
#define WAIT_L(n) asm volatile("s_waitcnt lgkmcnt(" #n ")" ::: "memory")
#define SETPRIO(x) __builtin_amdgcn_s_setprio(x)
#define SCHED_BAR() __builtin_amdgcn_sched_barrier(0)
#define RFL(x) __builtin_amdgcn_readfirstlane(x)
#define GRID_SYNC_CG() cg::this_grid().sync()
#define LDS_BAR() do { asm volatile("s_waitcnt lgkmcnt(0)" ::: "memory"); __builtin_amdgcn_s_barrier(); asm volatile("" ::: "memory"); } while (0)
#define GRID_SYNC() do { for (int _r = 0; _r < REP_SYNC; ++_r) xcd_barrier(gbar); } while (0)
#define WAVE_SYNC() __builtin_amdgcn_wave_barrier()
#define OPAQUE(x) asm volatile("" : "+v"(x))
#define OPAQUE_S(x) asm volatile("" : "+s"(x))
#define BALLOT(p) __ballot(p)
#define POPCLL(x) __popcll(x)
#define DPP_F(v, ctrl) __builtin_bit_cast(float, __builtin_amdgcn_update_dpp(0, __builtin_bit_cast(int, (float)(v)), ctrl, 0xF, 0xF, true))
#define DPP_XOR1(v) DPP_F(v, 0xB1)
#define DPP_XOR2(v) DPP_F(v, 0x4E)
#define DPP_HMIRROR(v) DPP_F(v, 0x141)
#define DPP_QBCAST(v, j) DPP_F(v, (j) * 0x55)
#define LDS_TR4(p) __builtin_amdgcn_ds_read_tr16_b64_v4i16((LAS s16x4*)(p))
#endif

__device__ __forceinline__ float bf2f(bf16_t h) { return __builtin_bit_cast(float, (unsigned)h << 16); }
__device__ __forceinline__ bf16_t f2bf(float f) { unsigned u = __builtin_bit_cast(unsigned, f); u += 0x7fffu + ((u >> 16) & 1u); return (bf16_t)(u >> 16); }
__device__ __forceinline__ unsigned pack_bf16(float lo, float hi) {
#ifdef HIP_EMU
    return (unsigned)f2bf(lo) | ((unsigned)f2bf(hi) << 16);
#else
    typedef float f32x2_t __attribute__((ext_vector_type(2))); typedef __bf16 bf16x2_t __attribute__((ext_vector_type(2)));
    const f32x2_t f = {lo, hi}; const bf16x2_t h = __builtin_convertvector(f, bf16x2_t); return __builtin_bit_cast(unsigned, h);
#endif
}
#ifdef HIP_EMU
__device__ __forceinline__ float fexp(float x) { return expf(x); }
__device__ __forceinline__ float fexp2(float x) { return exp2f(x); }
#define BPERM_F(idx4, v) __shfl(v, (idx4) >> 2)
__device__ __forceinline__ float frcp(float x) { return 1.0f / x; }
__device__ __forceinline__ float frsq(float x) { return 1.0f / sqrtf(x); }
__device__ __forceinline__ float flog(float x) { return logf(x); }
#else
__device__ __forceinline__ float fexp(float x) { return __expf(x); }
__device__ __forceinline__ float fexp2(float x) { return __builtin_amdgcn_exp2f(x); }
#define BPERM_F(idx4, v) __builtin_bit_cast(float, __builtin_amdgcn_ds_bpermute(idx4, __builtin_bit_cast(int, (float)(v))))
__device__ __forceinline__ float frcp(float x) { return __builtin_amdgcn_rcpf(x); }
__device__ __forceinline__ float frsq(float x) { return __builtin_amdgcn_rsqf(x); }
__device__ __forceinline__ float flog(float x) { return __logf(x); }
#endif
#ifdef HIP_EMU
__device__ __forceinline__ float fma_(float a, float b, float c) { return a * b + c; }
__device__ __forceinline__ float mul_(float a, float b) { return a * b; }
__device__ __forceinline__ float add_(float a, float b) { return a + b; }
#else
__device__ __forceinline__ float fma_(float a, float b, float c) { float d; asm("v_fma_f32 %0, %1, %2, %3" : "=v"(d) : "v"(a), "v"(b), "v"(c)); return d; }
__device__ __forceinline__ float mul_(float a, float b) { float d; asm("v_mul_f32 %0, %1, %2" : "=v"(d) : "v"(a), "v"(b)); return d; }
__device__ __forceinline__ float add_(float a, float b) { float d; asm("v_add_f32 %0, %1, %2" : "=v"(d) : "v"(a), "v"(b)); return d; }
#endif
__device__ __forceinline__ float sigmoidf_(float x) { return frcp(1.0f + fexp(-x)); }
__device__ __forceinline__ float siluf_(float x) { return x * frcp(1.0f + fexp(-x)); }
__device__ __forceinline__ float ftanh(float x) { return 1.0f - 2.0f * frcp(fexp(2.0f * x) + 1.0f); }
__device__ __forceinline__ float logsigmoidf_(float x) { return fminf(x, 0.0f) - flog(1.0f + fexp(-fabsf(x))); }
__device__ __forceinline__ void split8(const float (&x)[8], bf16x8& hi, bf16x8& lo) {
    u32x4 h, l;
#pragma unroll
    for (int i = 0; i < 4; ++i) { const unsigned hp = pack_bf16(x[2 * i], x[2 * i + 1]);
        const float f0 = __builtin_bit_cast(float, hp << 16), f1 = __builtin_bit_cast(float, hp & 0xffff0000u);
        h[i] = hp; l[i] = pack_bf16(x[2 * i] - f0, x[2 * i + 1] - f1); }
    hi = __builtin_bit_cast(bf16x8, h); lo = __builtin_bit_cast(bf16x8, l);
}
#define TRKEY(r) ((((r) >> 1) & 1) | ((((r) >> 3) & 1) << 1))
__device__ __forceinline__ int tr_off(int row, int tile, int p) { return row * 64 + (((tile ^ TRKEY(row)) & 3) << 4) + p * 4; }
__device__ __forceinline__ bf16x8 tr_read8(const bf16_t* img, int rbase, int tile, int lane) {
    const int q = (lane & 15) >> 2, p = lane & 3, r0 = rbase + (lane >> 4) * 8 + q;
    const s16x4 a = LDS_TR4(img + tr_off(r0, tile, p)), b = LDS_TR4(img + tr_off(r0 + 4, tile, p));
    return __builtin_shufflevector(a, b, 0, 1, 2, 3, 4, 5, 6, 7);
}
__device__ __forceinline__ bf16x8 tr_read8_ld(const bf16_t* img, int ld, int rbase, int tile, int lane) {
    const int q = (lane & 15) >> 2, p = lane & 3, r0 = rbase + (lane >> 4) * 8 + q;
    const s16x4 a = LDS_TR4(img + r0 * ld + tile * 16 + p * 4), b = LDS_TR4(img + (r0 + 4) * ld + tile * 16 + p * 4);
    return __builtin_shufflevector(a, b, 0, 1, 2, 3, 4, 5, 6, 7);
}
__device__ __forceinline__ bf16x8 tr_read8_ld_perm(const bf16_t* img, int ld, int rbase, int tile, int lane) {
    const int q = (lane & 15) >> 2, p = lane & 3, r0 = rbase + (lane >> 4) * 4 + q;
    const s16x4 a = LDS_TR4(img + r0 * ld + tile * 16 + p * 4), b = LDS_TR4(img + (r0 + 16) * ld + tile * 16 + p * 4);
    return __builtin_shufflevector(a, b, 0, 1, 2, 3, 4, 5, 6, 7);
}
__device__ __forceinline__ float red8(float v) { v += DPP_XOR1(v); v += DPP_XOR2(v); v += DPP_HMIRROR(v); return v; }

#ifdef HIP_EMU
__device__ __forceinline__ float wave_scan_add(float v) { const int l = emu_cur->lane; auto t = emu_wave_gather(&v, 1); float s = 0.f; for (int i = 0; i <= l; ++i) { float x; memcpy(&x, &t[i][0], 4); s += x; } return s; }
__device__ __forceinline__ float wave_scan_max(float v) { const int l = emu_cur->lane; auto t = emu_wave_gather(&v, 1); float s = -INFINITY; for (int i = 0; i <= l; ++i) { float x; memcpy(&x, &t[i][0], 4); s = fmaxf(s, x); } return s; }
#else
#define DPP_UPD(oldv, v, ctrl, rmask) __builtin_bit_cast(float, __builtin_amdgcn_update_dpp(__builtin_bit_cast(int, (float)(oldv)), __builtin_bit_cast(int, (float)(v)), ctrl, rmask, 0xF, false))
__device__ __forceinline__ float wave_scan_add(float v) {
    v += DPP_UPD(0.f, v, 0x111, 0xF); v += DPP_UPD(0.f, v, 0x112, 0xF); v += DPP_UPD(0.f, v, 0x114, 0xF); v += DPP_UPD(0.f, v, 0x118, 0xF);
    v += DPP_UPD(0.f, v, 0x142, 0xA); v += DPP_UPD(0.f, v, 0x143, 0xC); return v;
}
__device__ __forceinline__ float wave_scan_max(float v) {
    const float ninf = -__builtin_inff();
    v = fmaxf(v, DPP_UPD(ninf, v, 0x111, 0xF)); v = fmaxf(v, DPP_UPD(ninf, v, 0x112, 0xF)); v = fmaxf(v, DPP_UPD(ninf, v, 0x114, 0xF)); v = fmaxf(v, DPP_UPD(ninf, v, 0x118, 0xF));
    v = fmaxf(v, DPP_UPD(ninf, v, 0x142, 0xA)); v = fmaxf(v, DPP_UPD(ninf, v, 0x143, 0xC)); return v;
}
#endif
__device__ __forceinline__ float wave_sum(float v) {
    v += __shfl_xor(v, 32); v += __shfl_xor(v, 16); v += __shfl_xor(v, 8); v += __shfl_xor(v, 4); v += __shfl_xor(v, 2); v += __shfl_xor(v, 1); return v;
}

#ifdef SMALL_CFG
constexpr bool WS_OVERLAY = false;
#else
constexpr bool WS_OVERLAY = true;
#endif
constexpr size_t al256(size_t x) { return (x + 255) / 256 * 256; }
constexpr size_t cmax(size_t a, size_t b) { return a > b ? a : b; }
constexpr size_t SZ_PC = al256((size_t)NTOK * CONV_CH * 2), SZ_PT = al256((size_t)NTOK * P2_LD * 2), SZ_P = SZ_PC + SZ_PT;
constexpr size_t SZ_H = al256((size_t)NTOK * D_MODEL * 2);
constexpr size_t SZ_U = al256((size_t)NTOK * CONV_CH * 2);
constexpr size_t SZ_O = al256((size_t)NLAT * D_MODEL * 4);
constexpr size_t SZ_HID = al256((size_t)ROWS_P * D_EXPERT * 2);
constexpr size_t SZ_XM = al256((size_t)(NLAT + 1) * D_MODEL * 2);
constexpr size_t SZ_YPAIR = al256((size_t)ROWS_P * D_MODEL * 2);
constexpr size_t WS_P = 0, WS_PC = 0, WS_PT = WS_PC + SZ_PC;
constexpr size_t WS_R2 = WS_P + SZ_P;
constexpr size_t SZ_R2 = WS_OVERLAY ? cmax(cmax(SZ_H, SZ_U), cmax(SZ_O, SZ_HID)) : SZ_H + SZ_U + SZ_O + SZ_HID;
constexpr size_t WS_H = WS_R2;
constexpr size_t WS_U = WS_OVERLAY ? WS_R2 : WS_H + SZ_H;
constexpr size_t WS_O = WS_OVERLAY ? WS_R2 : WS_U + SZ_U;
constexpr size_t WS_X1 = WS_O;
constexpr size_t SZ_OB = al256((size_t)NLAT * D_MODEL * 2);
constexpr size_t WS_HID = WS_OVERLAY ? WS_P + SZ_YPAIR : WS_O + SZ_O;
constexpr size_t WS_WGU = WS_R2 + SZ_R2;
constexpr size_t WS_WDN = WS_WGU + al256((size_t)N_EXPERTS * 2 * D_EXPERT * D_MODEL * 2);
constexpr size_t WS_WIN = WS_WDN + al256((size_t)N_EXPERTS * D_MODEL * D_EXPERT * 2);
constexpr size_t WS_WOUT = WS_WIN + al256((size_t)IN_PAD * D_MODEL * 2);
constexpr int GK = 256;
static_assert(IN_COLS - OFF_LWB == GK && W_R % 256 == 0, "g GEMM layout");
constexpr size_t WS_GBT = WS_WOUT + al256((size_t)D_MODEL * MIX_W * 2);
constexpr size_t WS_MOD = WS_GBT + al256((size_t)W_R * GK * 2);
constexpr size_t WS_EIDX = WS_MOD + al256((size_t)(BATCH + 1) * 6 * D_MODEL * 4);
constexpr size_t WS_EWT = WS_EIDX + al256((size_t)N_PAIRS * 4);
constexpr size_t WS_DEST = WS_EWT + al256((size_t)N_PAIRS * 4);
constexpr size_t WS_CCNT = WS_DEST + al256((size_t)N_PAIRS * 4);
constexpr size_t WS_TOKBUF = WS_CCNT + al256((size_t)MAX_GRID * N_EXPERTS * 4);
constexpr size_t WS_WBUF = WS_TOKBUF + al256((size_t)ROWS_P * 4);
constexpr size_t WS_BLKEXP = WS_WBUF + al256((size_t)ROWS_P * 4);
constexpr size_t WS_BON = WS_BLKEXP + al256((size_t)(MAX_RB + 64) * 4);
constexpr size_t WS_BAR = WS_BON + al256((size_t)NLAT * H_R * 4);
constexpr size_t WS_END = WS_BAR + al256((size_t)3456 * 4);
constexpr size_t WS_XM = WS_OVERLAY ? WS_R2 + SZ_OB : WS_END;
constexpr size_t WS_YPAIR = WS_OVERLAY ? WS_P : WS_XM + SZ_XM;
constexpr size_t WS_TOTAL = WS_OVERLAY ? WS_END : WS_YPAIR + SZ_YPAIR;
static_assert(!WS_OVERLAY || (SZ_YPAIR + SZ_HID <= SZ_P && SZ_OB + SZ_XM <= SZ_R2), "xm / ypair / hidden overlays");
static_assert(WS_TOTAL <= ((size_t)1 << 30), "workspace > 1 GiB");

namespace pg8 {
constexpr int BM = 256, BK = 64, HALF = 128, HTB = HALF * BK * 2, STAGE_BYTES = 8 * HTB, NXCD = 8, WGM = 16;
__host__ __device__ __forceinline__ int lds_byte(int r, int c) { const int st = (r >> 4) * 2 + (c >> 5), rr = r & 15, cc = c & 31, ob = rr * 64 + cc * 2; return st * 1024 + (ob ^ (((ob >> 9) & 1) << 5)); }
__host__ __device__ __forceinline__ void stage_rc(int b, int& R, int& C) { const int st = b / 1024, sb = b % 1024, swz = sb ^ (((sb >> 9) & 1) << 5); R = (st >> 1) * 16 + swz / 64; C = (st & 1) * 32 + (swz % 64) / 2; }
__host__ __device__ __forceinline__ int perm32(int rho) { const int n = rho >> 4, i = rho & 15; return 8 * (i >> 2) + 4 * n + (i & 3); }
struct Unit { int pm, pn; };
struct Gemm { const bf16_t* A; const bf16_t* Bt; int K; int lda; const int* a_rows; const int* blk_exp; size_t b_stride; int seg_tiles, seg_stride, seg_off; };
__device__ __forceinline__ int tile_row0(const Gemm& g, int pm) { return g.seg_tiles ? (pm / g.seg_tiles) * g.seg_stride + g.seg_off + (pm % g.seg_tiles) * BM : pm * BM; }
struct StaticOrder {
    int nM, nN, nwg, G, c;
    __host__ __device__ void init(int M, int N, int G_, int c_) { nM = M / BM; nN = N / BM; nwg = nM * nN; G = G_; c = c_; }
    __host__ __device__ bool next(int i, Unit& u) const {
        const long L = (long)i * G + c; if (L >= nwg) return false;
        int wgid = (int)L; { const int q = nwg / NXCD, r = nwg % NXCD, xcd = wgid % NXCD, off = wgid / NXCD; wgid = (xcd < r ? xcd * (q + 1) : r * (q + 1) + (xcd - r) * q) + off; }
        const int nig = WGM * nN, gid = wgid / nig, fm = gid * WGM, gsz = (nM - fm) < WGM ? (nM - fm) : WGM;
        u.pm = fm + ((wgid % nig) % gsz); u.pn = (wgid % nig) / gsz; return true;
    }
};
struct OwnTile {
    int first, step, nT, nN;
    __host__ __device__ bool next(int i, Unit& u) const { const int t = first + (i / nN) * step; if (t >= nT) return false; u.pm = t; u.pn = i % nN; return true; }
};
struct EpiF32 {
    static constexpr bool PERM = false, MAPPED = false; static constexpr int NST = 32; float* C; int ldc;
    __device__ __forceinline__ bool full(const Unit&) const { return true; }
    __device__ __forceinline__ void operator()(const f32x4 (&acc)[2][2][4][2], const Unit& u, int r0, int wr, int wc, int fr, int fq) const {
        const int row0 = r0 + wr * 64 + fr, col0 = u.pn * BM + wc * 32 + 4 * fq;
#pragma unroll
        for (int ai = 0; ai < 2; ++ai)
#pragma unroll
            for (int m = 0; m < 4; ++m) { float* rowp = C + (size_t)(row0 + ai * HALF + m * 16) * ldc + col0;
#pragma unroll
                for (int bj = 0; bj < 2; ++bj)
#pragma unroll
                    for (int n = 0; n < 2; ++n) *(f32x4*)(rowp + bj * HALF + n * 16) = acc[ai][bj][m][n]; }
    }
};
struct EpiBf16 {
    static constexpr bool PERM = true, MAPPED = false; static constexpr int NST = 16; bf16_t* O; int ldc; int n_valid; const float* row_scale;
    __device__ __forceinline__ bool full(const Unit& u) const { return (u.pn + 1) * BM <= n_valid; }
    __device__ __forceinline__ void operator()(const f32x4 (&acc)[2][2][4][2], const Unit& u, int r0, int wr, int wc, int fr, int fq) const {
        const int row0 = r0 + wr * 64 + fr, col0 = u.pn * BM + wc * 32 + 8 * fq;
#pragma unroll
        for (int ai = 0; ai < 2; ++ai)
#pragma unroll
            for (int m = 0; m < 4; ++m) { const int row = row0 + ai * HALF + m * 16; bf16_t* rowp = O + (size_t)row * ldc + col0; const float sc = row_scale ? row_scale[row] : 1.0f;
#pragma unroll
                for (int bj = 0; bj < 2; ++bj) { const f32x4 v0 = acc[ai][bj][m][0] * sc, v1 = acc[ai][bj][m][1] * sc;
                    u32x4 w; w.x = pack_bf16(v0[0], v0[1]); w.y = pack_bf16(v0[2], v0[3]); w.z = pack_bf16(v1[0], v1[1]); w.w = pack_bf16(v1[2], v1[3]);
                    if (col0 + bj * HALF < n_valid) *(u32x4*)(rowp + bj * HALF) = w; } }
    }
};
struct EpiInProj {
    static constexpr bool PERM = true, MAPPED = false; static constexpr int NST = 16; bf16_t* Pc; bf16_t* Pt;
    __device__ __forceinline__ bool full(const Unit& u) const { return (u.pn + 1) * BM <= IN_COLS; }
    __device__ __forceinline__ void operator()(const f32x4 (&acc)[2][2][4][2], const Unit& u, int r0, int wr, int wc, int fr, int fq) const {
        static_assert(CONV_CH % BM == 0, "a column tile must not straddle the slab-major / token-major seam");
        const int row0 = r0 + wr * 64 + fr, col0 = u.pn * BM + wc * 32 + 8 * fq;
        const bool conv = (u.pn + 1) * BM <= CONV_CH;
        bf16_t* base0; bf16_t* base1; size_t rstride;
        if (conv) { base0 = Pc + pc_off(col0, row0); base1 = Pc + pc_off(col0 + HALF, row0); rstride = 64; }
        else { base0 = Pt + (size_t)row0 * P2_LD + (col0 - CONV_CH); base1 = base0 + HALF; rstride = P2_LD; }
        const bool ok0 = col0 < IN_COLS, ok1 = col0 + HALF < IN_COLS;
#pragma unroll
        for (int ai = 0; ai < 2; ++ai)
#pragma unroll
            for (int m = 0; m < 4; ++m) { const size_t ro = (size_t)(ai * HALF + m * 16) * rstride;
#pragma unroll
                for (int bj = 0; bj < 2; ++bj) { const f32x4 v0 = acc[ai][bj][m][0], v1 = acc[ai][bj][m][1];
                    u32x4 w; w.x = pack_bf16(v0[0], v0[1]); w.y = pack_bf16(v0[2], v0[3]); w.z = pack_bf16(v1[0], v1[1]); w.w = pack_bf16(v1[2], v1[3]);
                    if (bj ? ok1 : ok0) *(u32x4*)((bj ? base1 : base0) + ro) = w; } }
    }
};
struct EpiBf16Mapped : EpiBf16 { static constexpr bool MAPPED = true; };
struct EpiSwiGLU {
    static constexpr bool PERM = false, MAPPED = false; static constexpr int NST = 16; bf16_t* H; int ldh;
    __device__ __forceinline__ bool full(const Unit&) const { return true; }
    __device__ __forceinline__ void operator()(const f32x4 (&acc)[2][2][4][2], const Unit& u, int r0, int wr, int wc, int fr, int fq) const {
        const int row0 = r0 + wr * 64 + fr, col0 = u.pn * (BM / 2) + wc * 16 + 4 * fq;
#pragma unroll
        for (int ai = 0; ai < 2; ++ai)
#pragma unroll
            for (int m = 0; m < 4; ++m) { bf16_t* rowp = H + (size_t)(row0 + ai * HALF + m * 16) * ldh + col0;
#pragma unroll
                for (int bj = 0; bj < 2; ++bj) { const f32x4 gv = acc[ai][bj][m][0], uv = acc[ai][bj][m][1];
                    u32x2 w; w.x = pack_bf16(siluf_(gv[0]) * uv[0], siluf_(gv[1]) * uv[1]); w.y = pack_bf16(siluf_(gv[2]) * uv[2], siluf_(gv[3]) * uv[3]);
                    *(u32x2*)(rowp + bj * (HALF / 2)) = w; } }
    }
};

template <class Epi, class Sched, bool GATHER>
__device__ __forceinline__ void gemm_phase(LAS unsigned char* lds, const Gemm g, const Sched& S, const Epi& E) {
    int tid = threadIdx.x; OPAQUE(tid);
    const int wid = RFL(tid >> 6), lane = tid & 63, wr = wid >> 2, wc = wid & 3, fr = lane & 15, fq = lane >> 4;
    const int K = g.K, nt = K / BK;
    int sR[2], sC[2];
    unsigned voffA[2], voffB[2];
#pragma unroll
    for (int i = 0; i < 2; ++i) { int R, C; stage_rc(tid * 16 + i * 8192, R, C); sR[i] = R; sC[i] = C; const int Rb = Epi::PERM ? ((R & ~31) + perm32(R & 31)) : R;
        voffA[i] = (unsigned)(R * g.lda + C) * 2u; voffB[i] = (unsigned)(Rb * K + C) * 2u; }
    const size_t kstep = (size_t)(BK * 2);
    const size_t hstep = (size_t)HALF * K * 2, hstepA = (size_t)HALF * g.lda * 2;
    const size_t tstep = 2 * hstep;
    const unsigned ldsw = (unsigned)wid * 1024u;
    const int aoff = lds_byte(wr * 64 + fr, fq * 8), boff = lds_byte(wc * 32 + fr, fq * 8);
#define PG8_SA(b, h) (((b) * 2 + (h)) * HTB)
#define PG8_SB(b, h) ((4 + (b) * 2 + (h)) * HTB)
#define PG8_STAGE(bufoff, gbase, voff) do { _Pragma("unroll") for (int _i = 0; _i < 2; ++_i) \
        GLDS16((const char*)(gbase) + (voff)[_i], lds + (bufoff) + ldsw + _i * 8192); } while (0)
#define PG8_STAGE_A(b, h, kofs, usenext) do { if constexpr (GATHER) { PG8_STAGE(PG8_SA(b, h), (const char*)g.A + (kofs), (usenext) ? vAn[h] : vAc[h]); } \
        else { PG8_STAGE(PG8_SA(b, h), ((usenext) ? nA : cA) + (size_t)(h) * hstepA + (kofs), voffA); } } while (0)
#define PG8_LDA(dst, b, h) do { _Pragma("unroll") for (int m = 0; m < 4; ++m) _Pragma("unroll") for (int k = 0; k < 2; ++k) dst[m][k] = *(const LAS bf16x8*)(lds + PG8_SA(b, h) + aoff + m * 2048 + k * 1024); } while (0)
#define PG8_LDB(dst, b, h) do { _Pragma("unroll") for (int n = 0; n < 2; ++n) _Pragma("unroll") for (int k = 0; k < 2; ++k) dst[n][k] = *(const LAS bf16x8*)(lds + PG8_SB(b, h) + boff + n * 2048 + k * 1024); } while (0)
#define PG8_MMA(ai, bj, At, Bt) do { SETPRIO(1); _Pragma("unroll") for (int m = 0; m < 4; ++m) _Pragma("unroll") for (int n = 0; n < 2; ++n) _Pragma("unroll") for (int k = 0; k < 2; ++k) \
        acc[ai][bj][m][n] = MFMA16(Bt[n][k], At[m][k], acc[ai][bj][m][n]); SETPRIO(0); } while (0)
#define PG8_GATHER_OFFS(u, v) do { _Pragma("unroll") for (int _h = 0; _h < 2; ++_h) _Pragma("unroll") for (int _i = 0; _i < 2; ++_i) { \
        const int _row = g.a_rows[(u).pm * BM + _h * HALF + sR[_i]]; v[_h][_i] = (unsigned)(_row * g.lda + sC[_i]) * 2u; } } while (0)
    Unit cur, nxt; int ui = 0;
    if (!S.next(0, cur)) return;
    f32x4 acc[2][2][4][2];
#pragma unroll
    for (int a = 0; a < 2; ++a)
#pragma unroll
        for (int b = 0; b < 2; ++b)
#pragma unroll
            for (int m = 0; m < 4; ++m)
#pragma unroll
                for (int n = 0; n < 2; ++n) acc[a][b][m][n] = (f32x4){0.f, 0.f, 0.f, 0.f};
    bf16x8 At[4][2], B0[2][2], B1[2][2];
    unsigned vAc[2][2], vAn[2][2];
    if constexpr (GATHER) { PG8_GATHER_OFFS(cur, vAc); }
    else {
#pragma unroll
        for (int h = 0; h < 2; ++h)
#pragma unroll
            for (int i = 0; i < 2; ++i) { vAc[h][i] = 0u; vAn[h][i] = 0u; }
    }
    int cr0 = tile_row0(g, cur.pm);
    const char* cA = (const char*)g.A + (GATHER ? (size_t)0 : (size_t)cr0 * g.lda * 2);
    const char* cB = (const char*)g.Bt + (g.blk_exp ? (size_t)g.blk_exp[cur.pm] * g.b_stride * 2 : (size_t)0) + (size_t)cur.pn * tstep;
    const char* nA = cA;
    PG8_STAGE(PG8_SB(0, 0), cB, voffB); PG8_STAGE_A(0, 0, (size_t)0, false); PG8_STAGE(PG8_SB(0, 1), cB + hstep, voffB); PG8_STAGE_A(0, 1, (size_t)0, false);
    if (wr == 1) S_BARRIER();
    WAIT_V(4); S_BARRIER();
    PG8_STAGE(PG8_SB(1, 0), cB + kstep, voffB); PG8_STAGE_A(1, 0, kstep, false); PG8_STAGE(PG8_SB(1, 1), cB + hstep + kstep, voffB);
    WAIT_V(6); S_BARRIER();
    bool relax = false;
    for (;;) {
        const bool has_next = S.next(ui + 1, nxt);
        const int nr0 = has_next ? tile_row0(g, nxt.pm) : cr0;
        nA = (has_next && !GATHER) ? (const char*)g.A + (size_t)nr0 * g.lda * 2 : cA;
        const char* nB = has_next ? (const char*)g.Bt + (g.blk_exp ? (size_t)g.blk_exp[nxt.pm] * g.b_stride * 2 : (size_t)0) + (size_t)nxt.pn * tstep : cB;
        if constexpr (GATHER) {
            if (has_next) { PG8_GATHER_OFFS(nxt, vAn); }
            else {
#pragma unroll
                for (int h = 0; h < 2; ++h)
#pragma unroll
                    for (int i = 0; i < 2; ++i) vAn[h][i] = vAc[h][i];
            }
        }
        for (int t = 0; t < nt; t += 2) {
            const bool last = (t == nt - 2);
            const size_t k1 = (size_t)(t + 1) * kstep;
            const size_t k2 = last ? (size_t)0 : (size_t)(t + 2) * kstep, k3 = k2 + kstep;
            const char* b2 = last ? nB : cB + (size_t)(t + 2) * kstep; const char* b3 = b2 + kstep;
            PG8_LDB(B0, 0, 0); SCHED_BAR(); PG8_LDA(At, 0, 0); PG8_STAGE_A(1, 1, k1, false);
            WAIT_L(8); S_BARRIER(); WAIT_L(0); PG8_MMA(0, 0, At, B0); S_BARRIER(); SCHED_BAR();
            PG8_LDB(B1, 0, 1); PG8_STAGE(PG8_SB(0, 0), b2, voffB);
            S_BARRIER(); WAIT_L(0); PG8_MMA(0, 1, At, B1); S_BARRIER();
            PG8_LDA(At, 0, 1); PG8_STAGE_A(0, 0, k2, last);
            S_BARRIER(); WAIT_L(0); PG8_MMA(1, 0, At, B0); S_BARRIER(); SCHED_BAR();
            PG8_STAGE(PG8_SB(0, 1), b2 + hstep, voffB);
            if (!GATHER && t == 0 && relax) { WAIT_V_EPI(Epi::NST); } else { WAIT_V(6); }
            S_BARRIER(); PG8_MMA(1, 1, At, B1); S_BARRIER();
            PG8_LDB(B0, 1, 0); SCHED_BAR(); PG8_LDA(At, 1, 0); PG8_STAGE_A(0, 1, k2, last);
            WAIT_L(8); S_BARRIER(); WAIT_L(0); PG8_MMA(0, 0, At, B0); S_BARRIER(); SCHED_BAR();
            PG8_LDB(B1, 1, 1); PG8_STAGE(PG8_SB(1, 0), b3, voffB);
            if (!GATHER && t == 0 && relax) WAIT_V(10);
            S_BARRIER(); WAIT_L(0); PG8_MMA(0, 1, At, B1); S_BARRIER();
            PG8_LDA(At, 1, 1); PG8_STAGE_A(1, 0, k3, last);
            S_BARRIER(); WAIT_L(0); PG8_MMA(1, 0, At, B0); S_BARRIER(); SCHED_BAR();
            PG8_STAGE(PG8_SB(1, 1), b3 + hstep, voffB);
            WAIT_V(6);
            S_BARRIER(); PG8_MMA(1, 1, At, B1); S_BARRIER();
        }
        E(acc, cur, Epi::MAPPED ? cr0 : cur.pm * BM, wr, wc, fr, fq);
        if (!has_next) break;
        if constexpr (!GATHER) relax = E.full(cur);
#pragma unroll
        for (int a = 0; a < 2; ++a)
#pragma unroll
            for (int b = 0; b < 2; ++b)
#pragma unroll
                for (int m = 0; m < 4; ++m)
#pragma unroll
                    for (int n = 0; n < 2; ++n) acc[a][b][m][n] = (f32x4){0.f, 0.f, 0.f, 0.f};
        cur = nxt; cA = nA; cB = nB; cr0 = nr0; ++ui;
        if constexpr (GATHER) {
#pragma unroll
            for (int h = 0; h < 2; ++h)
#pragma unroll
                for (int i = 0; i < 2; ++i) vAc[h][i] = vAn[h][i];
        }
    }
    WAIT_V(0);
    if (wr == 0) S_BARRIER();
    S_BARRIER();
#undef PG8_SA
#undef PG8_SB
#undef PG8_STAGE
#undef PG8_STAGE_A
#undef PG8_LDA
#undef PG8_LDB
#undef PG8_MMA
#undef PG8_GATHER_OFFS
}
}


#ifndef HIP_EMU
#define XB_TMO      128
#define XB_XCNT(j)  (256  + 64 * (j))
#define XB_XSUB(j)  (1280 + 64 * (j))
#define XB_XGEN(j)  (2304 + 64 * (j))
#define XB_TOP      3328
#define XB_TOPGEN   3392
#define XCD_BAR_WORDS 3456
#define XB_SPIN_CAP (1u << 22)
__device__ __forceinline__ unsigned xb_ld(unsigned* p)              { return __hip_atomic_load(p, __ATOMIC_RELAXED, __HIP_MEMORY_SCOPE_AGENT); }
__device__ __forceinline__ unsigned xb_add(unsigned* p, unsigned v) { return __hip_atomic_fetch_add(p, v, __ATOMIC_RELAXED, __HIP_MEMORY_SCOPE_AGENT); }
__device__ __forceinline__ unsigned xb_xcc_id() { return (unsigned)__builtin_amdgcn_s_getreg((3 << 11) | 20) & 0xFu; }
#define XB_SPIN(cond, bar) do { unsigned _sp = 0; while (cond) { __builtin_amdgcn_s_sleep(1); \
    if ((++_sp & 255u) == 0u) { if (xb_ld(&(bar)[XB_TMO])) break; if (_sp > XB_SPIN_CAP) { atomicAdd(&(bar)[XB_TMO], 1u); break; } } } } while (0)
struct XcdBarrier { unsigned* bar; unsigned x; volatile LAS unsigned* st; };
__device__ __forceinline__ XcdBarrier xcd_barrier_post(unsigned* bar, volatile LAS unsigned* st) {
    XcdBarrier b; b.bar = bar; b.x = xb_xcc_id(); b.st = st;
    if (threadIdx.x == 0) (void)xb_add(&bar[XB_XCNT(b.x)], 1u);
    return b;
}
__device__ __forceinline__ void xcd_barrier_complete(unsigned* bar, unsigned x, unsigned& nloc, unsigned& nx) {
    const unsigned G = gridDim.x * gridDim.y * gridDim.z;
    unsigned sum, cnt, mine, sp = 0u;
    for (;;) {
        sum = 0u; cnt = 0u; mine = 0u;
#pragma unroll
        for (unsigned j = 0; j < 16; ++j) { const unsigned c = xb_ld(&bar[XB_XCNT(j)]); sum += c; cnt += (c > 0u) ? 1u : 0u; mine = (j == x) ? c : mine; }
        if (sum == G) break;
        __builtin_amdgcn_s_sleep(1);
        if ((++sp & 255u) == 0u) { if (xb_ld(&bar[XB_TMO])) break; if (sp > XB_SPIN_CAP) { atomicAdd(&bar[XB_TMO], 1u); break; } }
    }
    nloc = mine > 0u ? mine : 1u; nx = cnt > 0u ? cnt : 1u;
}
__device__ __forceinline__ void xcd_barrier_census(const XcdBarrier& b) {
    if (threadIdx.x < 64 && b.st[0] == 0u) {
        const unsigned G = gridDim.x * gridDim.y * gridDim.z; const int lane = threadIdx.x; unsigned sp = 0u, c = 0u;
        for (;;) {
            c = (lane < 16) ? xb_ld(&b.bar[XB_XCNT(lane)]) : 0u;
            unsigned sum = c;
#pragma unroll
            for (int o = 1; o < 16; o <<= 1) sum += (unsigned)__shfl_xor((int)sum, o);
            sum = (unsigned)__shfl((int)sum, 0);
            if (sum == G) break;
            __builtin_amdgcn_s_sleep(1);
            if ((++sp & 255u) == 0u) { if (xb_ld(&b.bar[XB_TMO])) break; if (sp > XB_SPIN_CAP) { if (lane == 0) atomicAdd(&b.bar[XB_TMO], 1u); break; } }
        }
        const unsigned long long nz = BALLOT(c > 0u); const unsigned mine = (unsigned)__shfl((int)c, (int)b.x);
        if (lane == 0) { b.st[0] = mine > 0u ? mine : 1u; b.st[1] = (unsigned)POPCLL(nz) > 0u ? (unsigned)POPCLL(nz) : 1u; }
    }
}
__device__ __forceinline__ void xcd_barrier(const XcdBarrier& b) {
    asm volatile("s_waitcnt vmcnt(0)" ::: "memory");
    __syncthreads();
    xcd_barrier_census(b);
    if (threadIdx.x == 0) {
        unsigned* bar = b.bar;
        __builtin_amdgcn_s_waitcnt(0);
        unsigned nloc = b.st[0], nx = b.st[1];
        if (nloc == 0u) { xcd_barrier_complete(bar, b.x, nloc, nx); b.st[0] = nloc; b.st[1] = nx; }
        const unsigned old = xb_add(&bar[XB_XSUB(b.x)], 1u);
        const unsigned gen = old / nloc;
        if (old + 1u == (gen + 1u) * nloc) {
            __builtin_amdgcn_fence(__ATOMIC_RELEASE, "agent");
            asm volatile("s_waitcnt vmcnt(0)" ::: "memory");
            const unsigned og = xb_add(&bar[XB_TOP], 1u);
            const unsigned tg = og / nx;
            if (og + 1u == (tg + 1u) * nx) xb_add(&bar[XB_TOPGEN], 1u);
            else XB_SPIN(xb_ld(&bar[XB_TOPGEN]) == tg, bar);
            __builtin_amdgcn_fence(__ATOMIC_ACQUIRE, "agent");
            xb_add(&bar[XB_XGEN(b.x)], 1u);
            asm volatile("s_waitcnt vmcnt(0)" ::: "memory");
        } else {
            XB_SPIN(xb_ld(&bar[XB_XGEN(b.x)]) == gen, bar);
            __builtin_amdgcn_fence(__ATOMIC_ACQUIRE, "agent");
            asm volatile("s_waitcnt vmcnt(0)" ::: "memory");
        }
    }
    __syncthreads();
}
#endif

struct Params {
    const float *x, *c, *ctx, *c_ctx, *w_ada, *b_ada, *w_in, *conv_w, *m_bias_i, *m_bias_f, *m_norm_w, *r_w0, *r_wB, *r_a0, *r_aB, *r_gB, *r_kk, *r_ka, *r_bonus,
        *r_norm_w, *r_norm_b, *w_out, *ln1_g, *ln1_b, *ln2_g, *ln2_b, *rt_g, *rt_g_b, *rt_e, *rt_e_b, *ex_gate, *ex_up, *ex_down;
    float* out; unsigned char* ws;
};

constexpr int CT_N = 256, CT_LD = CT_N + 1;
__device__ __forceinline__ void cvt_tile(const float* __restrict__ src, bf16_t* __restrict__ dst, int K, int N, int rows_out, int map_mode, int n0, int k0, float* tile, int tid) {
    __syncthreads();
    { const int n4 = (tid & 63) * 4, kb = tid >> 6, n = n0 + n4; const bool ok = n < N; const int nc = ok ? n : 0;
#pragma unroll
      for (int i = 0; i < 8; ++i) { const int kk = kb + 8 * i; f32x4 v = *(const f32x4*)(src + (size_t)(k0 + kk) * N + nc); if (!ok) v = (f32x4){0.f, 0.f, 0.f, 0.f};
          tile[kk * CT_LD + n4] = v[0]; tile[kk * CT_LD + n4 + 1] = v[1]; tile[kk * CT_LD + n4 + 2] = v[2]; tile[kk * CT_LD + n4 + 3] = v[3]; } }
    __syncthreads();
#pragma unroll
    for (int j = 0; j < 4; ++j) { const int o = tid + NTHREADS * j, nn = o >> 3, kg = (o & 7) * 8, n = n0 + nn; int row; bool ok;
        if (map_mode == 0) { row = n; ok = row < rows_out; } else { ok = n < N; row = 32 * (n / 16) + 16 * (map_mode - 1) + (n % 16); }
        if (ok) { const float* tp = tile + kg * CT_LD + nn; u32x4 w; w.x = pack_bf16(tp[0], tp[CT_LD]); w.y = pack_bf16(tp[2 * CT_LD], tp[3 * CT_LD]); w.z = pack_bf16(tp[4 * CT_LD], tp[5 * CT_LD]); w.w = pack_bf16(tp[6 * CT_LD], tp[7 * CT_LD]);
            *(u32x4*)(dst + (size_t)row * K + k0 + kg) = w; } }
}
__device__ __forceinline__ void phase_prologue(const Params& p, unsigned char* smem) {
    float* sf = (float*)smem;
    int tid = threadIdx.x; OPAQUE(tid); const int G = gridDim.x;
    float* mod = (float*)(p.ws + WS_MOD);
    constexpr int NJB = 6 * D_MODEL / NTHREADS, N_MODVB = (BATCH + 1) * NJB;
    constexpr int NT_WIN = (IN_PAD / CT_N) * (D_MODEL / 64), NT_WOUT = (D_MODEL / CT_N) * (MIX_W / 64);
    constexpr int TG = (D_EXPERT / CT_N) * (D_MODEL / 64), TD = (D_MODEL / CT_N) * (D_EXPERT / 64), NT_EXP = N_EXPERTS * (2 * TG + TD);
    constexpr int NT_GBT = (W_R * GK) / (NTHREADS * 8);
    static_assert(D_EXPERT % CT_N == 0 && D_MODEL % CT_N == 0 && (W_R * GK) % (NTHREADS * 8) == 0, "tile shapes");
    for (int vb = blockIdx.x; vb < N_MODVB + NT_WIN + NT_WOUT + NT_EXP + NT_GBT; vb += G) {
        if (vb < N_MODVB) {
            const int r = vb / NJB, j = (vb % NJB) * NTHREADS + tid;
            const float* src = (r < BATCH) ? p.c + (size_t)r * D_MODEL : p.c_ctx;
            __syncthreads();
            for (int k = tid; k < D_MODEL; k += NTHREADS) sf[k] = siluf_(src[k]);
            __syncthreads();
            float acc0 = 0.f, acc1 = 0.f, acc2 = 0.f, acc3 = 0.f;
            for (int k = 0; k < D_MODEL; k += 4) { acc0 += sf[k] * p.w_ada[(size_t)k * (6 * D_MODEL) + j]; acc1 += sf[k + 1] * p.w_ada[(size_t)(k + 1) * (6 * D_MODEL) + j];
                acc2 += sf[k + 2] * p.w_ada[(size_t)(k + 2) * (6 * D_MODEL) + j]; acc3 += sf[k + 3] * p.w_ada[(size_t)(k + 3) * (6 * D_MODEL) + j]; }
            mod[(size_t)r * 6 * D_MODEL + j] = (acc0 + acc1) + (acc2 + acc3) + p.b_ada[j];
        } else if (vb < N_MODVB + NT_WIN) {
            const int t = vb - N_MODVB; cvt_tile(p.w_in, (bf16_t*)(p.ws + WS_WIN), D_MODEL, IN_COLS, IN_PAD, 0, (t % (IN_PAD / CT_N)) * CT_N, (t / (IN_PAD / CT_N)) * 64, sf, tid);
        } else if (vb < N_MODVB + NT_WIN + NT_WOUT) {
            const int t = vb - N_MODVB - NT_WIN; cvt_tile(p.w_out, (bf16_t*)(p.ws + WS_WOUT), MIX_W, D_MODEL, D_MODEL, 0, (t % (D_MODEL / CT_N)) * CT_N, (t / (D_MODEL / CT_N)) * 64, sf, tid);
        } else if (vb < N_MODVB + NT_WIN + NT_WOUT + NT_EXP) {
            const int v2 = vb - N_MODVB - NT_WIN - NT_WOUT, e = v2 / (2 * TG + TD), r = v2 % (2 * TG + TD);
            bf16_t* wgu = (bf16_t*)(p.ws + WS_WGU); bf16_t* wdn = (bf16_t*)(p.ws + WS_WDN);
            if (r < 2 * TG) { const int which = r / TG, t = r % TG;
                cvt_tile((which ? p.ex_up : p.ex_gate) + (size_t)e * D_MODEL * D_EXPERT, wgu + (size_t)e * 2 * D_EXPERT * D_MODEL, D_MODEL, D_EXPERT, 2 * D_EXPERT, 1 + which,
                         (t % (D_EXPERT / CT_N)) * CT_N, (t / (D_EXPERT / CT_N)) * 64, sf, tid);
            } else { const int t = r - 2 * TG;
                cvt_tile(p.ex_down + (size_t)e * D_EXPERT * D_MODEL, wdn + (size_t)e * D_MODEL * D_EXPERT, D_EXPERT, D_MODEL, D_MODEL, 0, (t % (D_MODEL / CT_N)) * CT_N, (t / (D_MODEL / CT_N)) * 64, sf, tid); }
        } else {
            const int t = vb - N_MODVB - NT_WIN - NT_WOUT - NT_EXP; bf16_t* gbt = (bf16_t*)(p.ws + WS_GBT);
            const int o = (t * NTHREADS + tid) * 8, n = o / GK, k0 = o % GK; u32x4 w = (u32x4){0u, 0u, 0u, 0u};
            if (k0 >= GK - G_LORA) { const float* gp = p.r_gB + (size_t)(k0 - (GK - G_LORA)) * W_R + n;
                w.x = pack_bf16(gp[0], gp[W_R]); w.y = pack_bf16(gp[2 * W_R], gp[3 * W_R]); w.z = pack_bf16(gp[4 * W_R], gp[5 * W_R]); w.w = pack_bf16(gp[6 * W_R], gp[7 * W_R]); }
            *(u32x4*)(gbt + o) = w;
        }
    }
}

constexpr int NV4 = D_MODEL / 256;
__device__ __forceinline__ void phase_ln_mod(const Params& p) {
    int tid = threadIdx.x; OPAQUE(tid); const int lane = tid & 63, wid = tid >> 6;
    const float* mod = (const float*)(p.ws + WS_MOD); bf16_t* h = (bf16_t*)(p.ws + WS_H);
    const int stride = gridDim.x * NWAVES;
    f32x4 nv[NV4];
#define LM_LOAD(gg) do { const int _b = (gg) / T_ALL, _t = (gg) % T_ALL; \
        const float* _src = (_t < CTX_LEN) ? p.ctx + ((size_t)_b * CTX_LEN + _t) * D_MODEL : p.x + ((size_t)_b * SEQ + (_t - CTX_LEN)) * D_MODEL; \
        _Pragma("unroll") for (int i = 0; i < NV4; ++i) nv[i] = *(const f32x4*)(_src + 4 * lane + 256 * i); } while (0)
    if (blockIdx.x * NWAVES + wid < NTOK) LM_LOAD(blockIdx.x * NWAVES + wid);
    for (int g = blockIdx.x * NWAVES + wid; g < NTOK; g += stride) {
        const int b = g / T_ALL, t = g % T_ALL;
        const float* m = mod + (size_t)((t < CTX_LEN) ? BATCH : b) * 6 * D_MODEL;
        f32x4 v[NV4]; float s = 0.f;
#pragma unroll
        for (int i = 0; i < NV4; ++i) { v[i] = nv[i]; s += (v[i][0] + v[i][1]) + (v[i][2] + v[i][3]); }
        f32x4 shv[NV4], scv[NV4];
#pragma unroll
        for (int i = 0; i < NV4; ++i) { const int k = 4 * lane + 256 * i; shv[i] = *(const f32x4*)(m + k); scv[i] = *(const f32x4*)(m + D_MODEL + k); }
        LM_LOAD(g + stride < NTOK ? g + stride : g);
        const float mu = wave_sum(s) * (1.0f / D_MODEL);
        float q = 0.f;
#pragma unroll
        for (int i = 0; i < NV4; ++i) { const f32x4 d = v[i] - mu; q += (d[0] * d[0] + d[1] * d[1]) + (d[2] * d[2] + d[3] * d[3]); }
        const float rstd = rsqrtf(wave_sum(q) * (1.0f / D_MODEL) + LN_EPS);
#pragma unroll
        for (int i = 0; i < NV4; ++i) { const int k = 4 * lane + 256 * i; const f32x4 sh = shv[i], sc = scv[i];
            const f32x4 o = (v[i] - mu) * rstd * (sc + 1.0f) + sh; u32x2 w; w.x = pack_bf16(o[0], o[1]); w.y = pack_bf16(o[2], o[3]);
            *(u32x2*)(h + (size_t)g * D_MODEL + k) = w; }
    }
#undef LM_LOAD
}

__device__ __forceinline__ int chunk_t0(int d, int c) {
    if (d == 0) return 64 * c;
    if (c < NC_CTX) return CTX_LEN - 64 * (c + 1);
    return CTX_LEN + SEQ - 64 * (c - NC_CTX + 1);
}

constexpr int LP = 72;
__device__ __forceinline__ void unpack8(const u32x4 w, float (&f)[8]) {
    f[0] = __builtin_bit_cast(float, w.x << 16); f[1] = __builtin_bit_cast(float, w.x & 0xffff0000u); f[2] = __builtin_bit_cast(float, w.y << 16); f[3] = __builtin_bit_cast(float, w.y & 0xffff0000u);
    f[4] = __builtin_bit_cast(float, w.z << 16); f[5] = __builtin_bit_cast(float, w.z & 0xffff0000u); f[6] = __builtin_bit_cast(float, w.w << 16); f[7] = __builtin_bit_cast(float, w.w & 0xffff0000u);
}
constexpr int CV_BAND = 4;
__device__ __forceinline__ u32x4 conv_post_pack(float (&acc)[8], int col0) {
    if (col0 < 2 * W_M) { const float sc = (col0 >= W_M) ? 0.125f : 1.0f;
#pragma unroll
        for (int j = 0; j < 8; ++j) acc[j] = siluf_(acc[j]) * sc; }
    u32x4 w; w.x = pack_bf16(acc[0], acc[1]); w.y = pack_bf16(acc[2], acc[3]); w.z = pack_bf16(acc[4], acc[5]); w.w = pack_bf16(acc[6], acc[7]); return w;
}
__device__ __forceinline__ void phase_conv(const Params& p, unsigned char* smem, bool dry) {
    constexpr int IMG = 6 * 66 * 8;
    u32x4* img = (u32x4*)smem;
    float* wl = (float*)(smem + (size_t)2 * IMG * 16);
    float* cwl = wl + 2 * 576;
    int tid = threadIdx.x; OPAQUE(tid); const int G = gridDim.x;
    bf16_t* Pc = (bf16_t*)(p.ws + WS_PC); bf16_t* Pt = (bf16_t*)(p.ws + WS_PT); bf16_t* U = (bf16_t*)(p.ws + WS_U);
    constexpr int NSLAB = CONV_CH / 64, NBAND = BATCH * (GRID_ROWS / CV_BAND), CTX_SPLIT = 4, NCTXU = BATCH * NC_CTX * CTX_SPLIT, NCG = CONV_CH / 8, NITEM = GRID_W * NCG;
    static_assert(CV_BAND == 4 && GRID_ROWS % CV_BAND == 0 && GRID_W * 8 == NTHREADS, "conv band shapes");
    const u32x4 zero4 = (u32x4){0u, 0u, 0u, 0u};
    __syncthreads();
    for (int i = tid; i < 2 * 6 * 2 * 8; i += NTHREADS) { const int bq = i / (6 * 2 * 8), r = (i / 16) % 6, side = (i / 8) & 1, g8 = i & 7; img[bq * IMG + (r * 66 + (side ? 65 : 0)) * 8 + g8] = zero4; }
    for (int i = tid; i < 3 * CONV_CH; i += NTHREADS) cwl[i] = p.conv_w[3 * CONV_CH + i];
    __syncthreads();
    const int x = tid >> 3, cgl = tid & 7;
    for (int bd = blockIdx.x; bd < NBAND + NCTXU; bd += G) {
        if (bd < NBAND) {
            const int b = bd / (GRID_ROWS / CV_BAND), r0 = (bd % (GRID_ROWS / CV_BAND)) * CV_BAND;
            const int tokl = b * T_ALL + CTX_LEN;
            const bf16_t* ldp = Pc + pc_off(cgl * 8, tokl + x); bf16_t* stp = U + pc_off(cgl * 8, tokl + x);
            u32x4 va[6], vb[6]; f32x4 wa = (f32x4){0.f, 0.f, 0.f, 0.f}, wb = wa;
#define CV_ISSUE(V, W, sl) do { _Pragma("unroll") for (int ry = 0; ry < 6; ++ry) { const int y = r0 - 1 + ry; const bool ok = (y >= 0 && y < GRID_ROWS); \
                const u32x4 t4 = *(const u32x4*)(ldp + (size_t)(sl) * ((size_t)NTOK * 64) + (ok ? y : r0) * (GRID_W * 64)); V[ry] = t4; } \
                if (tid < 144) W = *(const f32x4*)(p.conv_w + (size_t)(tid >> 4) * CONV_CH + (sl) * 64 + (tid & 15) * 4); } while (0)
#define CV_SLAB(V, W, sl) do { \
                u32x4* im = img + ((sl) & 1) * IMG; float* wls = wl + ((sl) & 1) * 576; \
                _Pragma("unroll") for (int ry = 0; ry < 6; ++ry) { const int y = r0 - 1 + ry; im[(ry * 66 + x + 1) * 8 + cgl] = (y >= 0 && y < GRID_ROWS) ? V[ry] : zero4; } \
                if (tid < 144) *(f32x4*)(wls + (tid >> 4) * 64 + (tid & 15) * 4) = W; \
                if ((sl) + 2 < NSLAB) CV_ISSUE(V, W, (sl) + 2); \
                LDS_BAR(); \
                const int col0 = (sl) * 64 + cgl * 8; \
                float acc[4][8]; \
                _Pragma("unroll") for (int r = 0; r < 4; ++r) _Pragma("unroll") for (int j = 0; j < 8; ++j) acc[r][j] = 0.f; \
                _Pragma("unroll 1") for (int kx = 0; kx < 3; ++kx) { \
                    f32x4 w0[3], w1[3]; \
                    _Pragma("unroll") for (int ky = 0; ky < 3; ++ky) { w0[ky] = *(const f32x4*)(wls + (ky * 3 + kx) * 64 + cgl * 8); w1[ky] = *(const f32x4*)(wls + (ky * 3 + kx) * 64 + cgl * 8 + 4); } \
                    _Pragma("unroll") for (int iy = 0; iy < 6; ++iy) { float f[8]; unpack8(im[(iy * 66 + x + kx) * 8 + cgl], f);     \
                        _Pragma("unroll") for (int ky = 0; ky < 3; ++ky) { const int rp = iy - ky; if (rp >= 0 && rp < 4) { \
                            _Pragma("unroll") for (int j = 0; j < 4; ++j) { acc[rp][j] += f[j] * w0[ky][j]; acc[rp][4 + j] += f[4 + j] * w1[ky][j]; } } } } } \
                _Pragma("unroll") for (int rp = 0; rp < 4; ++rp) *(u32x4*)(stp + (size_t)(sl) * ((size_t)NTOK * 64) + (r0 + rp) * (GRID_W * 64)) = conv_post_pack(acc[rp], col0); } while (0)
            static_assert(NSLAB % 2 == 0, "slab pairs");
            CV_ISSUE(va, wa, 0); CV_ISSUE(vb, wb, 1);
            for (int sl = 0; sl < NSLAB; sl += 2) { CV_SLAB(va, wa, sl); CV_SLAB(vb, wb, sl + 1); }
#undef CV_ISSUE
#undef CV_SLAB
            if (!dry) for (int it = tid; it < CV_BAND * GRID_W * (G_LORA / 8); it += NTHREADS) {
                bf16_t* q = Pt + ((size_t)b * T_ALL + CTX_LEN + r0 * GRID_W + it / (G_LORA / 8)) * P2_LD + T_LG + (it % (G_LORA / 8)) * 8;
                float f[8]; unpack8(*(const u32x4*)q, f);
                u32x4 w; w.x = pack_bf16(sigmoidf_(f[0]), sigmoidf_(f[1])); w.y = pack_bf16(sigmoidf_(f[2]), sigmoidf_(f[3])); w.z = pack_bf16(sigmoidf_(f[4]), sigmoidf_(f[5])); w.w = pack_bf16(sigmoidf_(f[6]), sigmoidf_(f[7]));
                *(u32x4*)q = w; }
            if (!dry) for (int it = tid; it < CV_BAND * GRID_W * (2 * W_LORA / 8); it += NTHREADS) {
                bf16_t* q = Pt + ((size_t)b * T_ALL + CTX_LEN + r0 * GRID_W + it / (2 * W_LORA / 8)) * P2_LD + T_LWF + (it % (2 * W_LORA / 8)) * 8;
                float f[8]; unpack8(*(const u32x4*)q, f);
                u32x4 w; w.x = pack_bf16(ftanh(f[0]), ftanh(f[1])); w.y = pack_bf16(ftanh(f[2]), ftanh(f[3])); w.z = pack_bf16(ftanh(f[4]), ftanh(f[5])); w.w = pack_bf16(ftanh(f[6]), ftanh(f[7]));
                *(u32x4*)q = w; }
            __syncthreads();
        } else {
            const int cu3 = bd - NBAND, cu2 = cu3 / CTX_SPLIT, part = cu3 % CTX_SPLIT, b = cu2 / NC_CTX, t00 = (cu2 % NC_CTX) * 64;
            const int tokb = b * T_ALL;
            for (int it = part * (NITEM / CTX_SPLIT) + tid; it < (part + 1) * (NITEM / CTX_SPLIT); it += NTHREADS) {
                const int i = it / NCG, col0 = (it % NCG) * 8, t = t00 + i; float acc[8];
#pragma unroll
                for (int j = 0; j < 8; ++j) acc[j] = 0.f;
#pragma unroll
                for (int kx = 0; kx < 3; ++kx) { const int tt = t + kx - 1; const bool ok = (tt >= 0 && tt < CTX_LEN);
                    const u32x4 raw = *(const u32x4*)(Pc + pc_off(col0, tokb + (ok ? tt : t))); float f[8]; unpack8(ok ? raw : zero4, f);
                    const f32x4 w0 = *(const f32x4*)(cwl + kx * CONV_CH + col0), w1 = *(const f32x4*)(cwl + kx * CONV_CH + col0 + 4);
#pragma unroll
                    for (int j = 0; j < 4; ++j) { acc[j] += f[j] * w0[j]; acc[4 + j] += f[4 + j] * w1[j]; } }
                *(u32x4*)(U + pc_off(col0, tokb + t)) = conv_post_pack(acc, col0);
            }
            static_assert(OFF_LWB == OFF_LWF + W_LORA && OFF_LA == OFF_LWB + W_LORA && (64 * (2 * W_LORA / 8)) % CTX_SPLIT == 0, "tanh pass layout");
            if (!dry) for (int it = part * (64 * (2 * W_LORA / 8) / CTX_SPLIT) + tid; it < (part + 1) * (64 * (2 * W_LORA / 8) / CTX_SPLIT); it += NTHREADS) {
                bf16_t* q = Pt + ((size_t)tokb + t00 + it / (2 * W_LORA / 8)) * P2_LD + T_LWF + (it % (2 * W_LORA / 8)) * 8;
                float f[8]; unpack8(*(const u32x4*)q, f);
                u32x4 w; w.x = pack_bf16(ftanh(f[0]), ftanh(f[1])); w.y = pack_bf16(ftanh(f[2]), ftanh(f[3])); w.z = pack_bf16(ftanh(f[4]), ftanh(f[5])); w.w = pack_bf16(ftanh(f[6]), ftanh(f[7]));
                *(u32x4*)q = w; }
        }
    }
}

constexpr int SL = 32, LT = 40;
#define RW_LOADC(buf, g) do { _Pragma("unroll") for (int jj = 0; jj < 4; ++jj) { if ((g) < 4) c0[buf][jj] = *(const f32x4*)(cq + (4 * (g) + jj) * 36); c1[buf][jj] = *(const f32x4*)(cq + (4 * (g) + jj) * 36 + 4); } } while (0)
#define RW_COEF(jj, i) ((i) < 4 ? c0[g & 1][jj][(i) & 3] : c1[g & 1][jj][(i) & 3])
#define RW_PIVOT(jj) do { const float ub = DPP_QBCAST(xp[g >> 1][g & 1], jj); const int i0 = (jj == 3 ? g + 1 : g); \
        if (i0 & 1) xp[i0 >> 1][1] = __builtin_fmaf(ub, RW_COEF(jj, i0), xp[i0 >> 1][1]); \
        _Pragma("unroll") for (int k = (i0 + 1) >> 1; k < 4; ++k) xp[k] = __builtin_elementwise_fma((f32x2){ub, ub}, (f32x2){RW_COEF(jj, 2 * k), RW_COEF(jj, 2 * k + 1)}, xp[k]); } while (0)
__device__ __forceinline__ void rw_tinv(const float* NbaT, bf16_t* TinvT, int tid) {
    const int j3 = tid >> 7, row = (tid >> 2) & 31, q3 = tid & 3;
    f32x2 xp[4];
#pragma unroll
    for (int k = 0; k < 4; ++k) { xp[k][0] = (8 * k + q3 == row) ? 1.0f : 0.0f; xp[k][1] = (8 * k + 4 + q3 == row) ? 1.0f : 0.0f; }
    const float* cq = NbaT + j3 * SL * 36 + q3 * 8;
    f32x4 c0[2][4], c1[2][4];
    RW_LOADC(0, 0);
#pragma unroll
    for (int g = 0; g < 8; ++g) {
        if (g + 1 < 8) RW_LOADC((g + 1) & 1, g + 1);
        RW_PIVOT(0); RW_PIVOT(1); RW_PIVOT(2); RW_PIVOT(3);
    }
    bf16_t* td = TinvT + (j3 * SL + q3) * LT + row;
#pragma unroll
    for (int k = 0; k < 4; ++k) { const unsigned w = pack_bf16(xp[k][0], xp[k][1]); td[(8 * k) * LT] = (bf16_t)(w & 0xffff); td[(8 * k + 4) * LT] = (bf16_t)(w >> 16); }
}
#undef RW_PIVOT
#undef RW_COEF
#undef RW_LOADC

template <int DIR> __device__ __forceinline__ void rwkv_job(const Params& p, int job, unsigned char* smem) {
    constexpr int LAMLD = 68;
    float* Lam = (float*)smem;
    float* a_s = Lam + 68 * LAMLD;
    bf16_t* TinvT = (bf16_t*)(a_s + 64 * LAMLD); bf16_t* NbrT = TinvT + 2 * SL * LT; float* Ypart1 = (float*)(NbrT + 2 * SL * LT);
    bf16_t* Bw = (bf16_t*)(Ypart1 + 8 * 64 * 4); bf16_t* Ba = Bw + 64 * LP;
    bf16_t* Amat = Ba + 64 * LP; bf16_t* Bmat = Amat + 64 * LP; bf16_t* Cmat = Bmat + 64 * LP; bf16_t* Rmat = Cmat + 64 * LP;
    bf16_t* Vrm = Rmat + 64 * LP;
    float* WL = (float*)(Vrm + 64 * 64);
    float* segtot = WL + 128;
    bf16_t* NcaT = (bf16_t*)Lam; bf16_t* NcrT = NcaT + 2 * SL * LT;
    float* XR0 = (float*)(NcrT + 2 * SL * LT); float* Ypart0 = XR0 + 8 * 64 * 8;
    float* NbaT = segtot + 512; float* XR1 = NbaT + 2 * SL * 36;
    static_assert(2 * 2 * SL * LT * 2 + 8 * 64 * 8 * 4 + 8 * 64 * 4 * 4 <= (68 + 64) * LAMLD * 4, "rwkv LDS aliases");
    static_assert((2 * SL * LT + 2 * SL * LT) * 2 + 8 * 64 * 16 + 2 * 64 * LP * 2 + 4 * 64 * LP * 2 + 64 * 64 * 2 + (128 + 512 + 2 * SL * 36 + 8 * 64 * 8) * 4 + (68 + 64) * LAMLD * 4 <= LDS_BYTES, "rwkv LDS size");
    const bf16_t* P = (const bf16_t*)(p.ws + WS_P); const bf16_t* U = (const bf16_t*)(p.ws + WS_U);
    int tid = threadIdx.x; OPAQUE(tid);
    const int lane = tid & 63, wid = RFL(tid >> 6), l15 = lane & 15, lq = lane >> 4;
    const int z = job / H_R, h = job % H_R, b = z % BATCH; constexpr int d = DIR;
    const int hc0 = h * 64;
    const bf16_t* Ptb = (const bf16_t*)(p.ws + WS_PT) + (size_t)b * T_ALL * P2_LD; const int tokb = b * T_ALL;
    bf16_t* Pcw = (bf16_t*)(p.ws + WS_PC);
    const int ycol = (d ? OFF_RK : OFF_RR) + hc0;
    __syncthreads();
    for (int idx = tid; idx < 4096; idx += NTHREADS) { const int j = idx >> 6, ch = idx & 63;
        Bw[ch * LP + j] = f2bf(-LOG2E * p.r_wB[((size_t)d * W_LORA + j) * W_R + hc0 + ch]); Ba[ch * LP + j] = f2bf(-LOG2E * p.r_aB[(size_t)j * W_R + hc0 + ch]); }
    const int pi = tid >> 3, cg = tid & 7, c0 = cg * 8;
    const int ppi = d ? 63 - pi : pi, sj = ppi >> 5, st = ppi & 31;
    const int vbw = wid >> 1, kh = wid & 1;
    f32x4 yown1 = (f32x4){0.f, 0.f, 0.f, 0.f}, rt10 = yown1, rt11 = yown1;
    f32x4 ST[2];
    ST[0] = (f32x4){0.f, 0.f, 0.f, 0.f}; ST[1] = (f32x4){0.f, 0.f, 0.f, 0.f};
    u32x4 n_a0, n_a1, n_rr, n_rk, n_rv;
#define RW_PREFETCH(cn) do { const int _t = chunk_t0(d, (cn)) + pi; const bf16_t* _pr = Ptb + (size_t)_t * P2_LD; \
        { const bf16_t* _pa = Ptb + (size_t)(chunk_t0(d, (cn)) + (wid & 3) * 16 + l15) * P2_LD + ((wid >> 2) ? T_LA : (d ? T_LWB : T_LWF)) + lq * 8; n_a0 = *(const u32x4*)_pa; n_a1 = *(const u32x4*)(_pa + 32); } \
        n_rr = *(const u32x4*)(U + pc_off(OFF_RR + hc0 + c0, tokb + _t)); n_rk = *(const u32x4*)(U + pc_off(OFF_RK + hc0 + c0, tokb + _t)); n_rv = *(const u32x4*)(U + pc_off(OFF_RV + hc0 + c0, tokb + _t)); } while (0)
    RW_PREFETCH(0);
    float lbias[4];
#pragma unroll
    for (int cb = 0; cb < 4; ++cb) lbias[cb] = -LOG2E * ((wid >> 2) ? p.r_a0[hc0 + cb * 16 + l15] : p.r_w0[d * W_R + hc0 + cb * 16 + l15]);
#pragma unroll
    for (int cb = 0; cb < 4; ++cb) OPAQUE(lbias[cb]);
    const int sidx16 = ((d ? lane + 16 : lane - 16) & 63) << 2, sidx32 = ((d ? lane + 32 : lane - 32) & 63) << 2;
    f32x4 hkk0 = *(const f32x4*)(p.r_kk + hc0 + c0), hkk1 = *(const f32x4*)(p.r_kk + hc0 + c0 + 4), hka0 = *(const f32x4*)(p.r_ka + hc0 + c0), hka1 = *(const f32x4*)(p.r_ka + hc0 + c0 + 4);
    f32x4 hbw0 = *(const f32x4*)(p.r_bonus + hc0 + c0), hbw1 = *(const f32x4*)(p.r_bonus + hc0 + c0 + 4);
    asm volatile("" : "+v"(hkk0), "+v"(hkk1), "+v"(hka0), "+v"(hka1), "+v"(hbw0), "+v"(hbw1));
    u32x2 ypend0 = (u32x2){0u, 0u}, ypend1 = (u32x2){0u, 0u};
#define RW_STORE_Y(cc) do { const int _t0 = chunk_t0(d, (cc)), _vb = wid >> 1, _tb = wid & 1; _Pragma("unroll") for (int _j = 0; _j < 2; ++_j) { const int _pp = _j * SL + _tb * 16 + l15, _tt = _t0 + (d ? 63 - _pp : _pp); \
            if (_tt >= CTX_LEN) *(u32x2*)(Pcw + pc_off(ycol + _vb * 16 + lq * 4, tokb + _tt)) = _j ? ypend1 : ypend0; } } while (0)
#define RW_STEP2A(j, ACC0, ACC1, YY0, YY1, VF) do {     \
        u32x4 _sw; _sw.x = pack_bf16(ST[0][0], ST[0][1]); _sw.y = pack_bf16(ST[0][2], ST[0][3]); _sw.z = pack_bf16(ST[1][0], ST[1][1]); _sw.w = pack_bf16(ST[1][2], ST[1][3]); \
        const bf16x8 _sf = __builtin_bit_cast(bf16x8, _sw); VF = tr_read8(Vrm, (j) * SL, vbw, lane); \
        const f32x4 _z4 = (f32x4){0.f, 0.f, 0.f, 0.f}; \
        _Pragma("unroll") for (int _o = 0; _o < 2; ++_o) { const int _tb = _o ? 1 - kh : kh; \
            const bf16_t* _ar = Amat + ((j) * SL + _tb * 16 + l15) * LP + kh * 32 + lq * 4; const bf16_t* _rr = Rmat + ((j) * SL + _tb * 16 + l15) * LP + kh * 32 + lq * 4; \
            const u32x2 _a0 = *(const u32x2*)_ar, _a1 = *(const u32x2*)(_ar + 16), _r0 = *(const u32x2*)_rr, _r1 = *(const u32x2*)(_rr + 16); \
            const bf16x8 _af = __builtin_bit_cast(bf16x8, ((u32x4){_a0.x, _a0.y, _a1.x, _a1.y})), _rf = __builtin_bit_cast(bf16x8, ((u32x4){_r0.x, _r0.y, _r1.x, _r1.y})); \
            if (_o) { ACC1 = MFMA16(_af, _sf, _z4); YY1 = MFMA16(_sf, _rf, _z4); } else { ACC0 = MFMA16(_af, _sf, _z4); YY0 = MFMA16(_sf, _rf, _z4); } }     \
        _Pragma("unroll") for (int _q = 0; _q < 2; ++_q) { const bf16x8 _cf = tr_read8_ld(Cmat, LP, (j) * SL, 2 * kh + _q, lane); ST[_q] = MFMA16(_cf, VF, ST[_q]); } } while (0)
#define RW_STEP2B1(j, CA, CR) do { CA = *(const bf16x8*)(NcaT + ((j) * SL + kh * 16 + l15) * LT + lq * 8); CR = *(const bf16x8*)(NcrT + ((j) * SL + kh * 16 + l15) * LT + lq * 8); } while (0)
#define RW_STEP2B2(ACC0, ACC1, YY0, YY1, VF, CA, CR, RT0, RT1, YOWN, YP, XR) do { \
        ACC0 = MFMA16(CA, VF, ACC0); YY0 = MFMA16(VF, CR, YY0); \
        RT0 = kh ? ACC1 : ACC0; RT1 = kh ? ACC0 : ACC1; \
        *(f32x4*)((XR) + (wid * 64 + lane) * 8) = RT0; *(f32x4*)((XR) + (wid * 64 + lane) * 8 + 4) = RT1; \
        YOWN = YY0; *(f32x4*)((YP) + ((vbw * 2 + (1 - kh)) * 64 + lane) * 4) = YY1; } while (0)
#define RW_SOLVEFIN(j, RT0, RT1, YOWN, YP, XR, YPEND) do { \
        const f32x4 _r0 = RT0 + *(const f32x4*)((XR) + ((wid ^ 1) * 64 + lane) * 8), _r1 = RT1 + *(const f32x4*)((XR) + ((wid ^ 1) * 64 + lane) * 8 + 4); \
        u32x4 _rw; _rw.x = pack_bf16(_r0[0], _r0[1]); _rw.y = pack_bf16(_r0[2], _r0[3]); _rw.z = pack_bf16(_r1[0], _r1[1]); _rw.w = pack_bf16(_r1[2], _r1[3]); \
        const bf16x8 _rb = __builtin_bit_cast(bf16x8, _rw); const f32x4 _z4 = (f32x4){0.f, 0.f, 0.f, 0.f}; f32x4 _ut[2]; \
        _Pragma("unroll") for (int _b = 0; _b < 2; ++_b) { const bf16_t* _tr = TinvT + ((j) * SL + _b * 16 + l15) * LT + lq * 4; const u32x2 _t0 = *(const u32x2*)_tr, _t1 = *(const u32x2*)(_tr + 16); \
            _ut[_b] = MFMA16(__builtin_bit_cast(bf16x8, ((u32x4){_t0.x, _t0.y, _t1.x, _t1.y})), _rb, _z4); } \
        u32x4 _uw; _uw.x = pack_bf16(_ut[0][0], _ut[0][1]) ^ 0x80008000u; _uw.y = pack_bf16(_ut[0][2], _ut[0][3]) ^ 0x80008000u; _uw.z = pack_bf16(_ut[1][0], _ut[1][1]) ^ 0x80008000u; _uw.w = pack_bf16(_ut[1][2], _ut[1][3]) ^ 0x80008000u; \
        const bf16x8 _uf = __builtin_bit_cast(bf16x8, _uw);     \
        const bf16_t* _np = NbrT + ((j) * SL + kh * 16 + l15) * LT + lq * 4; const u32x2 _n0 = *(const u32x2*)_np, _n1 = *(const u32x2*)(_np + 16); \
        f32x4 _y = YOWN + *(const f32x4*)((YP) + ((vbw * 2 + kh) * 64 + lane) * 4); _y = MFMA16(_uf, __builtin_bit_cast(bf16x8, ((u32x4){_n0.x, _n0.y, _n1.x, _n1.y})), _y); \
        { u32x2 _w; _w.x = pack_bf16(_y[0], _y[1]); _w.y = pack_bf16(_y[2], _y[3]); YPEND = _w; } \
        _Pragma("unroll") for (int _q = 0; _q < 2; ++_q) { const bf16x8 _bf = tr_read8_ld_perm(Bmat, LP, (j) * SL, 2 * kh + _q, lane); ST[_q] = MFMA16(_bf, _uf, ST[_q]); \
            const f32x4 _wl = *(const f32x4*)(WL + (j) * 64 + (2 * kh + _q) * 16 + lq * 4); ST[_q] = ST[_q] * _wl; } } while (0)
    for (int c = 0; c < NC_ALL; ++c) {
        const int t0 = chunk_t0(d, c), t = t0 + pi;
        LDS_BAR();
        if (c > 0) RW_SOLVEFIN(1, rt10, rt11, yown1, Ypart1, XR1, ypend1);
#ifdef HIP_EMU_POISON
        LDS_BAR();
        { unsigned* ps = (unsigned*)smem; const int lo0 = 0, hi0 = (int)(((unsigned char*)Bw - smem) / 4), lo1 = (int)(((unsigned char*)Amat - smem) / 4), hi1 = (int)(((unsigned char*)(XR1 + 8 * 64 * 8) - smem) / 4);
          for (int i = lo0 + tid; i < hi0; i += NTHREADS) ps[i] = 0xFFFFFFFFu; for (int i = lo1 + tid; i < hi1; i += NTHREADS) ps[i] = 0xFFFFFFFFu; }
        LDS_BAR();
#endif
        float racc[8], kacc[8], vacc[8], kmv[8];
        bf16x8 afA[2];
        {
            const u32x4 a0r = n_a0, a1r = n_a1, rr = n_rr, rk = n_rk, rv = n_rv;
            unpack8(rr, racc); unpack8(rk, kacc); unpack8(rv, vacc);
            *(u32x4*)(Vrm + ppi * 64 + ((((cg >> 1) ^ TRKEY(ppi)) & 3) << 4) + (cg & 1) * 8) = rv;
            afA[0] = __builtin_bit_cast(bf16x8, a0r); afA[1] = __builtin_bit_cast(bf16x8, a1r);
            if (c > 0) RW_STORE_Y(c - 1);
        }
        for (int rep2 = 0; rep2 < REP_RW_S2; ++rep2)
        {
            const int path = wid >> 2, tb = wid & 3; const bf16_t* B = path ? Ba : Bw;
            const float sgi = path ? 1.0f : 1.0f / (-DECAY_SCALE * LOG2E);
            f32x4 acc[4];
#pragma unroll
            for (int cb = 0; cb < 4; ++cb) acc[cb] = (f32x4){lbias[cb], lbias[cb], lbias[cb], lbias[cb]};
#pragma unroll
            for (int kk = 0; kk < 2; ++kk) { const bf16x8 af = afA[kk];
#pragma unroll
                for (int cb = 0; cb < 4; ++cb) { const bf16x8 bfr = *(const bf16x8*)(B + (cb * 16 + l15) * LP + kk * 32 + lq * 8); acc[cb] = MFMA16(af, bfr, acc[cb]); } }
#pragma unroll
            for (int cb = 0; cb < 4; ++cb) { const int ch = cb * 16 + l15;
                float val[4];
#pragma unroll
                for (int r = 0; r < 4; ++r) { const float e = fexp2(acc[cb][r]); val[r] = frcp(__builtin_fmaf(e, sgi, sgi)); }
                if (path) {
#pragma unroll
                    for (int r = 0; r < 4; ++r) { const int tok = tb * 16 + lq * 4 + r, pp = d ? 63 - tok : tok; a_s[pp * LAMLD + ch] = val[r]; } }
                else {
                    float tot;
                    if (!d) { val[1] += val[0]; val[2] += val[1]; val[3] += val[2]; tot = val[3]; } else { val[2] += val[3]; val[1] += val[2]; val[0] += val[1]; tot = val[0]; }
                    float inc = tot;
                    { const float t1 = BPERM_F(sidx16, inc); inc += (d ? lq < 3 : lq > 0) ? t1 : 0.f; }
                    { const float t2 = BPERM_F(sidx32, inc); inc += (d ? lq < 2 : lq > 1) ? t2 : 0.f; }
                    const float excl = inc - tot;
#pragma unroll
                    for (int r = 0; r < 4; ++r) { const int tok = tb * 16 + lq * 4 + r, pp = d ? 63 - tok : tok; Lam[((pp >> 4) * 17 + 1 + (pp & 15)) * LAMLD + ch] = val[r] + excl; }
                    Lam[((d ? 3 - tb : tb) * 17) * LAMLD + ch] = 0.f;
                } }
        }
        LDS_BAR();
        for (int rep3 = 0; rep3 < REP_RW_S3; ++rep3)
        {
            float off[8];
            {   const int orow = (ppi & 16) ? ((ppi >> 4) - 1) * 17 + 16 : (ppi >> 4) * 17;
                const f32x4 x0 = *(const f32x4*)(Lam + orow * LAMLD + c0), x1 = *(const f32x4*)(Lam + orow * LAMLD + c0 + 4);
#pragma unroll
                for (int j = 0; j < 4; ++j) { off[j] = x0[j]; off[4 + j] = x1[j]; } }
            const int lrow = (ppi >> 4) * 17 + 1 + (ppi & 15);
            const f32x4 l0 = *(const f32x4*)(Lam + lrow * LAMLD + c0), l1 = *(const f32x4*)(Lam + lrow * LAMLD + c0 + 4);
            const f32x4 m0 = *(const f32x4*)(Lam + (lrow - 1) * LAMLD + c0), m1 = *(const f32x4*)(Lam + (lrow - 1) * LAMLD + c0 + 4);
            const f32x4 a0 = *(const f32x4*)(a_s + ppi * LAMLD + c0), a1 = *(const f32x4*)(a_s + ppi * LAMLD + c0 + 4);
            const f32x4 kk0 = hkk0, kk1 = hkk1, ka0 = hka0, ka1 = hka1, bw0 = hbw0, bw1 = hbw1;
            float lam[8], lprev[8], av[8], kkv[8], kav[8];
#pragma unroll
            for (int j = 0; j < 4; ++j) { lam[j] = l0[j] + off[j]; lam[4 + j] = l1[j] + off[4 + j];
                lprev[j] = m0[j] + off[j]; lprev[4 + j] = m1[j] + off[4 + j];
                av[j] = a0[j]; av[4 + j] = a1[j]; kkv[j] = kk0[j]; kkv[4 + j] = kk1[j]; kav[j] = ka0[j]; kav[4 + j] = ka1[j]; }
            float kap[8], ss = 0.f;
#pragma unroll
            for (int j = 0; j < 8; ++j) { kap[j] = kacc[j] * kkv[j]; ss += kap[j] * kap[j]; }
            ss = red8(ss);
            const float inv = frsq(fmaxf(ss, 1e-24f));
            float am[8], bm[8], cm[8], rm[8], wvv[8];
#pragma unroll
            for (int j = 0; j < 8; ++j) { const float wv = fexp2(lam[j]), wp = fexp2(lprev[j]), wi = frcp(wv); wvv[j] = wv;
                const float kh = kap[j] * inv, km = kacc[j] * (1.0f + (av[j] - 1.0f) * kav[j]);
                am[j] = wp * kh; bm[j] = kh * av[j] * wi; cm[j] = km * wi; rm[j] = racc[j] * wv; if (d == 0) kmv[j] = km; }
            if (st == SL - 1) { *(f32x4*)(WL + sj * 64 + c0) = (f32x4){wvv[0], wvv[1], wvv[2], wvv[3]}; *(f32x4*)(WL + sj * 64 + c0 + 4) = (f32x4){wvv[4], wvv[5], wvv[6], wvv[7]}; }
            u32x4 w; w.x = pack_bf16(am[0], am[1]); w.y = pack_bf16(am[2], am[3]); w.z = pack_bf16(am[4], am[5]); w.w = pack_bf16(am[6], am[7]); *(u32x4*)(Amat + ppi * LP + c0) = w;
            u32x4 bw4, cw4;
            bw4.x = pack_bf16(bm[0], bm[1]); bw4.y = pack_bf16(bm[2], bm[3]); bw4.z = pack_bf16(bm[4], bm[5]); bw4.w = pack_bf16(bm[6], bm[7]); *(u32x4*)(Bmat + ppi * LP + c0) = bw4;
            cw4.x = pack_bf16(cm[0], cm[1]); cw4.y = pack_bf16(cm[2], cm[3]); cw4.z = pack_bf16(cm[4], cm[5]); cw4.w = pack_bf16(cm[6], cm[7]); *(u32x4*)(Cmat + ppi * LP + c0) = cw4;
            w.x = pack_bf16(rm[0], rm[1]); w.y = pack_bf16(rm[2], rm[3]); w.z = pack_bf16(rm[4], rm[5]); w.w = pack_bf16(rm[6], rm[7]); *(u32x4*)(Rmat + ppi * LP + c0) = w;
        }
        LDS_BAR();
        if (d == 0) {
            float bon = 0.f;
#pragma unroll
            for (int j = 0; j < 4; ++j) { bon += racc[j] * kmv[j] * hbw0[j]; bon += racc[4 + j] * kmv[4 + j] * hbw1[j]; }
            bon = red8(bon);
            if (cg == 0 && t >= CTX_LEN) ((float*)(p.ws + WS_BON))[((size_t)b * SEQ + (t - CTX_LEN)) * H_R + h] = bon;
        }
        RW_PREFETCH(c + 1 < NC_ALL ? c + 1 : c);
        for (int rep5 = 0; rep5 < REP_RW_MM; ++rep5)
        {
            const int j = wid >> 2, mt = wid & 3;
            const bf16_t* Arow = ((mt == 0 || mt == 3) ? Bmat : Cmat) + j * SL * LP; const bf16_t* Brow = ((mt <= 1) ? Amat : Rmat) + j * SL * LP;
            bf16x8 afr[2][2], bfr[2][2];
#pragma unroll
            for (int b2 = 0; b2 < 2; ++b2)
#pragma unroll
                for (int kk = 0; kk < 2; ++kk) { afr[b2][kk] = *(const bf16x8*)(Arow + (b2 * 16 + l15) * LP + kk * 32 + lq * 8); bfr[b2][kk] = *(const bf16x8*)(Brow + (b2 * 16 + l15) * LP + kk * 32 + lq * 8); }
            f32x4 acc4[2][2];
#pragma unroll
            for (int sb = 0; sb < 2; ++sb)
#pragma unroll
                for (int tb = 0; tb < 2; ++tb) { acc4[sb][tb] = (f32x4){0.f, 0.f, 0.f, 0.f};
                    if (sb <= tb) {
#pragma unroll
                        for (int kk = 0; kk < 2; ++kk) acc4[sb][tb] = MFMA16(afr[sb][kk], bfr[tb][kk], acc4[sb][tb]); } }
#pragma unroll
            for (int sb = 0; sb < 2; ++sb)
#pragma unroll
                for (int tb = 0; tb < 2; ++tb) {
                    const f32x4 acc = acc4[sb][tb];
                    const int tt = tb * 16 + l15, s0 = sb * 16 + lq * 4;
                    float vals[4];
#pragma unroll
                    for (int r = 0; r < 4; ++r) { if (sb == tb) { const int ss2 = s0 + r; const bool keep = (mt <= 1) ? (ss2 < tt) : (ss2 <= tt); vals[r] = keep ? acc[r] : 0.f; } else vals[r] = acc[r]; }
                    if (mt == 0) {
#pragma unroll
                        for (int r = 0; r < 4; ++r) NbaT[(j * SL + s0 + r) * 36 + (tt & 3) * 8 + (tt >> 2)] = -vals[r]; }
                    else { bf16_t* dst = (mt == 1 ? NcaT : mt == 2 ? NcrT : NbrT) + (j * SL + tt) * LT + s0;
                        u32x2 w; w.x = pack_bf16(vals[0], vals[1]); w.y = pack_bf16(vals[2], vals[3]);
                        *(u32x2*)dst = w; }
                }
        }
        f32x4 sa0, sa1, sy0, sy1; bf16x8 svf, sca, scr;
        RW_STEP2A(0, sa0, sa1, sy0, sy1, svf);
        LDS_BAR();
        f32x4 yown0, rt00, rt01;
        RW_STEP2B1(0, sca, scr);
        if (wid < 4) rw_tinv(NbaT, TinvT, tid);
        RW_STEP2B2(sa0, sa1, sy0, sy1, svf, sca, scr, rt00, rt01, yown0, Ypart0, XR0);
        LDS_BAR();
        RW_SOLVEFIN(0, rt00, rt01, yown0, Ypart0, XR0, ypend0);
        RW_STEP2A(1, sa0, sa1, sy0, sy1, svf); RW_STEP2B1(1, sca, scr);
        RW_STEP2B2(sa0, sa1, sy0, sy1, svf, sca, scr, rt10, rt11, yown1, Ypart1, XR1);
    }
    LDS_BAR();
    RW_SOLVEFIN(1, rt10, rt11, yown1, Ypart1, XR1, ypend1);
    RW_STORE_Y(NC_ALL - 1);
#undef RW_STORE_Y
#undef RW_STEP2A
#undef RW_STEP2B1
#undef RW_STEP2B2
#undef RW_SOLVEFIN
}

template <int DIR> __device__ __forceinline__ void mlstm_job(const Params& p, int job, unsigned char* smem) {
    bf16_t* q_s = (bf16_t*)smem;
    bf16_t* k_s = q_s + 2 * 64 * LP; bf16_t* kw_rm = k_s + 64 * LP; bf16_t* v_rm = kw_rm + 64 * 64;
    bf16_t* st = v_rm + 2 * 64 * 64; bf16_t* CT = st + 64 * LP;
    float* den_s = (float*)(CT + 80 * LP); float* G = den_s + 64;
    constexpr int GSZ = 384, G_A = 0, G_M = 64, G_INTER = 128, G_FLO = 192, G_WTS = 256, G_DECAY = 320;
    static_assert((2 * 64 + 64 + 64 + 80) * LP * 2 + 3 * 64 * 64 * 2 + (64 + 4 * GSZ) * 4 <= LDS_BYTES - 16, "mlstm LDS");
    const bf16_t* U = (const bf16_t*)(p.ws + WS_U);
    int tid = threadIdx.x; OPAQUE(tid);
    const int lane = tid & 63, wid = RFL(tid >> 6), l15 = lane & 15, lq = lane >> 4;
    const int z = job / H_M, h = job % H_M, b = z % BATCH; constexpr int d = DIR;
    const int hc0 = h * 64;
    const bf16_t* Ptb = (const bf16_t*)(p.ws + WS_PT) + (size_t)b * T_ALL * P2_LD; const int tokb = b * T_ALL;
    bf16_t* Pcw = (bf16_t*)(p.ws + WS_PC); const int hcol = (d ? OFF_MK : OFF_MQ) + hc0;
    __syncthreads();
    for (int idx = tid; idx < 80 * LP; idx += NTHREADS) CT[idx] = 0;
    const float bi = p.m_bias_i[d * H_M + h], bfg = p.m_bias_f[d * H_M + h];
    const int pi = tid >> 3, cg = tid & 7, c0 = cg * 8;
    const int pp = d ? 63 - pi : pi, wo_rm = pp * 64 + ((((cg >> 1) ^ TRKEY(pp)) & 3) << 4) + (cg & 1) * 8;
    const int pb = wid & 3, half = wid >> 2, NE = half ? 3 : 2, eb0 = half ? 2 : 0;
    const int pr = pb * 16 + l15;
    f32x4 cacc[3];
#pragma unroll
    for (int k = 0; k < 3; ++k) cacc[k] = (f32x4){0.f, 0.f, 0.f, 0.f};
    float m_run = 0.f;
    u32x4 n_q, n_k, n_v; bf16_t n_gi = 0, n_gf = 0;
#define ML_PREFETCH(cn) do { const int _t0 = chunk_t0(d, (cn)); \
        n_q = *(const u32x4*)(U + pc_off(OFF_MQ + hc0 + c0, tokb + _t0 + pi)); n_k = *(const u32x4*)(U + pc_off(OFF_MK + hc0 + c0, tokb + _t0 + pi)); n_v = *(const u32x4*)(Ptb + (size_t)(_t0 + pi) * P2_LD + T_MV + hc0 + c0); \
        if (tid < 64) { const int _i2 = d ? 63 - tid : tid; const bf16_t* _gt = Ptb + (size_t)(_t0 + _i2) * P2_LD + T_GATES; n_gi = _gt[(2 * d) * H_M + h]; n_gf = _gt[(2 * d + 1) * H_M + h]; } } while (0)
    float kval[8], yv[3][4]; f32x4 sacc[2], num[3];
    const bf16x8 ones8 = (bf16x8){0x3f80, 0x3f80, 0x3f80, 0x3f80, 0x3f80, 0x3f80, 0x3f80, 0x3f80}, zero8 = (bf16x8){0, 0, 0, 0, 0, 0, 0, 0};
#define ML_T1(cc) do { bf16_t* _qb = q_s + ((cc) & 1) * 64 * LP; const u32x4 _q = n_q, _k = n_k, _v = n_v; \
        *(u32x4*)(_qb + pp * LP + c0) = _q; *(u32x4*)(k_s + pp * LP + c0) = _k; unpack8(_k, kval); \
        *(u32x4*)(v_rm + ((cc) & 1) * 64 * 64 + wo_rm) = _v; \
        if (wid == 0) { float* _g = G + ((cc) & 3) * GSZ; const float _li = bf2f(n_gi) + bi, _lf = logsigmoidf_(bf2f(n_gf) + bfg); \
            const float _bs = wave_scan_add(_lf); const float _av = _li - _bs; const float _A = wave_scan_max(_av); \
            const float _M = fmaxf(m_run, _A); const float _M63 = __shfl(_M, 63), _b63 = __shfl(_bs, 63); \
            _g[G_A + lane] = _av; _g[G_M + lane] = _M; _g[G_INTER + lane] = fexp(m_run - _M); _g[G_FLO + lane] = fexp(-(_bs + _M)); _g[G_WTS + lane] = fexp(_av - _M63); \
            if (lane == 0) _g[G_DECAY] = fexp(m_run - _M63); \
            m_run = _b63 + _M63; } } while (0)
#define ML_T2(cc) do { const bf16_t* _qb = q_s + ((cc) & 1) * 64 * LP; _Pragma("unroll") for (int j = 0; j < 2; ++j) { sacc[j] = (f32x4){0.f, 0.f, 0.f, 0.f}; const int sb = 2 * half + j; \
        if (sb <= pb) { _Pragma("unroll") for (int kk = 0; kk < 2; ++kk) { const bf16x8 af = *(const bf16x8*)(_qb + (pb * 16 + l15) * LP + kk * 32 + lq * 8), bfr = *(const bf16x8*)(k_s + (sb * 16 + l15) * LP + kk * 32 + lq * 8); \
            sacc[j] = MFMA16(bfr, af, sacc[j]); } } } } while (0)
#define ML_T3(cc) do { const float* _g = G + ((cc) & 3) * GSZ; const float Mp = _g[G_M + pr]; \
        _Pragma("unroll") for (int j = 0; j < 2; ++j) { const int s0 = (2 * half + j) * 16 + lq * 4; const f32x4 as4 = *(const f32x4*)(_g + G_A + s0); float val[4]; \
            _Pragma("unroll") for (int r = 0; r < 4; ++r) { const float e = fexp(as4[r] - Mp); val[r] = (s0 + r <= pr) ? sacc[j][r] * e : 0.f; } \
            u32x2 w; w.x = pack_bf16(val[0], val[1]); w.y = pack_bf16(val[2], val[3]); *(u32x2*)(st + pr * LP + s0) = w; } \
        const float wt = _g[G_WTS + pp]; \
        { u32x4 w4; w4.x = pack_bf16(kval[0] * wt, kval[1] * wt); w4.y = pack_bf16(kval[2] * wt, kval[3] * wt); w4.z = pack_bf16(kval[4] * wt, kval[5] * wt); w4.w = pack_bf16(kval[6] * wt, kval[7] * wt); *(u32x4*)(kw_rm + wo_rm) = w4; } } while (0)
#define ML_T4(cc) do { const float* _g = G + ((cc) & 3) * GSZ; const bf16_t* _qb = q_s + ((cc) & 1) * 64 * LP; const bf16_t* _vb = v_rm + ((cc) & 1) * 64 * 64; const float decay = _g[G_DECAY], ip = _g[G_INTER + pr]; \
        _Pragma("unroll") for (int k = 0; k < 3; ++k) { num[k] = (f32x4){0.f, 0.f, 0.f, 0.f}; \
            if (k < NE) { const int eb = eb0 + k; f32x4 a1 = (f32x4){0.f, 0.f, 0.f, 0.f}, a2 = (f32x4){0.f, 0.f, 0.f, 0.f}; \
                _Pragma("unroll") for (int kk = 0; kk < 2; ++kk) { \
                    const bf16x8 qf = *(const bf16x8*)(_qb + (pb * 16 + l15) * LP + kk * 32 + lq * 8), cf = *(const bf16x8*)(CT + (eb * 16 + l15) * LP + kk * 32 + lq * 8); \
                    const bf16x8 sf = *(const bf16x8*)(st + (pb * 16 + l15) * LP + kk * 32 + lq * 8), vt_ = tr_read8(_vb, kk * 32, eb & 3, lane), vf = (eb == 4) ? ((l15 == 0) ? ones8 : zero8) : vt_;     \
                    const bf16x8 kf = tr_read8(kw_rm, kk * 32, pb, lane); \
                    a1 = MFMA16(cf, qf, a1); a2 = MFMA16(vf, sf, a2); \
                    if (kk == 0) cacc[k] = cacc[k] * decay; \
                    cacc[k] = MFMA16(kf, vf, cacc[k]); } \
                _Pragma("unroll") for (int r = 0; r < 4; ++r) num[k][r] = ip * a1[r] + a2[r]; \
                if (eb == 4 && lq == 0) den_s[pr] = num[k][0]; } } } while (0)
#define ML_T5(cc) do { const float dinv = frcp(fmaxf(fabsf(den_s[pr]), G[((cc) & 3) * GSZ + G_FLO + pr])); \
        _Pragma("unroll") for (int k = 0; k < 3; ++k) if (k < NE) { const int eb = eb0 + k; \
            if (eb < 4) { _Pragma("unroll") for (int r = 0; r < 4; ++r) yv[k][r] = num[k][r] * dinv; } \
            u32x2 w; w.x = pack_bf16(cacc[k][0], cacc[k][1]); w.y = pack_bf16(cacc[k][2], cacc[k][3]); *(u32x2*)(CT + (eb * 16 + l15) * LP + pb * 16 + lq * 4) = w; } } while (0)
#define ML_STORE_Y(cc) do { const int _tt = chunk_t0(d, (cc)) + (d ? 63 - pr : pr); if (_tt >= CTX_LEN) { _Pragma("unroll") for (int k = 0; k < 3; ++k) if (k < NE && eb0 + k < 4) { \
            u32x2 _w; _w.x = pack_bf16(yv[k][0], yv[k][1]); _w.y = pack_bf16(yv[k][2], yv[k][3]); *(u32x2*)(Pcw + pc_off(hcol + (eb0 + k) * 16 + lq * 4, tokb + _tt)) = _w; } } } while (0)
    ML_PREFETCH(0);
    ML_T1(0); ML_PREFETCH(1 < NC_ALL ? 1 : 0);
    LDS_BAR();
    ML_T2(0);
    LDS_BAR();
    ML_T3(0); ML_T1(1); ML_PREFETCH(2 < NC_ALL ? 2 : NC_ALL - 1);
    LDS_BAR();
    for (int c = 0; c < NC_ALL; ++c) {
        ML_T4(c); ML_T2(c + 1);
        LDS_BAR();
        ML_T5(c); ML_T3(c + 1); ML_T1(c + 2);
        ML_STORE_Y(c);
        ML_PREFETCH(c + 3 < NC_ALL ? c + 3 : NC_ALL - 1);
        LDS_BAR();
    }
#undef ML_PREFETCH
#undef ML_T1
#undef ML_T2
#undef ML_T3
#undef ML_T4
#undef ML_T5
#undef ML_STORE_Y
}

static_assert(W_M == W_R, "combine lane mapping assumes equal head groups");
__device__ __forceinline__ void phase_combine(const Params& p, int row_lo, int row_hi, int row_step, bool dry) {
    int tid = threadIdx.x; OPAQUE(tid); const int lane = tid & 63, wid = tid >> 6;
    bf16_t* Pc = (bf16_t*)(p.ws + WS_PC); bf16_t* Pt = (bf16_t*)(p.ws + WS_PT);
    constexpr int NPASS = W_M / 512 > 0 ? W_M / 512 : 1;
    constexpr int LANES_USED = W_M >= 512 ? 64 : W_M / 8;
    static_assert(NPASS == 1, "combine keeps one pass of per-lane constants and one row of prefetch in registers");
    const bool act = lane < LANES_USED; const int ch = lane * 8, chc = act ? ch : 0;
    const f32x4 nw0 = *(const f32x4*)(p.m_norm_w + chc), nw1 = *(const f32x4*)(p.m_norm_w + chc + 4);
    const f32x4 rw0 = *(const f32x4*)(p.r_norm_w + chc), rw1 = *(const f32x4*)(p.r_norm_w + chc + 4), rb0 = *(const f32x4*)(p.r_norm_b + chc), rb1 = *(const f32x4*)(p.r_norm_b + chc + 4);
    u32x4 n_hf, n_hb, n_mo, n_yf, n_yb, n_ybn, n_gg; float n_bon;
    const bf16_t* Uc = (const bf16_t*)(p.ws + WS_U); const float* bonb = (const float*)(p.ws + WS_BON);
#define CB_LOAD(r) do { const int _b = (r) / SEQ, _tok = _b * T_ALL + CTX_LEN + (r) % SEQ; const bf16_t* _pr = Pt + (size_t)_tok * P2_LD; \
        n_hf = *(const u32x4*)(Pc + pc_off(OFF_MQ + chc, _tok)); n_hb = *(const u32x4*)(Pc + pc_off(OFF_MK + chc, _tok)); n_mo = *(const u32x4*)(_pr + T_MO + chc); \
        n_yf = *(const u32x4*)(Pc + pc_off(OFF_RR + chc, _tok)); n_yb = *(const u32x4*)(Pc + pc_off(OFF_RK + chc, _tok)); n_ybn = *(const u32x4*)(Uc + pc_off(OFF_RV + chc, _tok)); n_bon = bonb[(size_t)(r) * H_R + chc / 64]; n_gg = *(const u32x4*)(_pr + T_MV + chc); } while (0)
    if (row_lo + wid < row_hi) CB_LOAD(row_lo + wid);
    for (int row = row_lo + wid; row < row_hi; row += row_step) {
        const int b = row / SEQ, l = row % SEQ;
        const int tok = b * T_ALL + CTX_LEN + l; bf16_t* prow = Pt + (size_t)tok * P2_LD;
        const u32x4 hf = n_hf, hb = n_hb, mo = n_mo, yf = n_yf, yb = n_yb, ybn = n_ybn, gg = n_gg; const float bonv = n_bon;
        { const int nr = row + row_step; CB_LOAD(nr < row_hi ? nr : row); }
        float a[8], c[8], e[8], sM[8], sR[8];
        unpack8(hf, a); unpack8(hb, c); float sum = 0.f;
#pragma unroll
        for (int j = 0; j < 8; ++j) { sM[j] = a[j] + c[j]; sum += sM[j]; }
        float mu = red8(sum) * (1.0f / 64.0f), q = 0.f;
#pragma unroll
        for (int j = 0; j < 8; ++j) { sM[j] -= mu; q += sM[j] * sM[j]; }
        float rstd = rsqrtf(red8(q) * (1.0f / 64.0f) + LN_EPS);
        unpack8(mo, e);
        float oM[8];
#pragma unroll
        for (int j = 0; j < 8; ++j) oM[j] = sM[j] * rstd * (j < 4 ? nw0[j] : nw1[j - 4]) * sigmoidf_(e[j]);
        unpack8(yf, a); unpack8(yb, c); sum = 0.f;
#pragma unroll
        for (int j = 0; j < 8; ++j) { sR[j] = a[j] + c[j]; sum += sR[j]; }
        mu = red8(sum) * (1.0f / 64.0f); q = 0.f;
#pragma unroll
        for (int j = 0; j < 8; ++j) { sR[j] -= mu; q += sR[j] * sR[j]; }
        rstd = rsqrtf(red8(q) * (1.0f / 64.0f) + GN_EPS);
        unpack8(ybn, a); unpack8(gg, c);
#pragma unroll
        for (int j = 0; j < 8; ++j) a[j] *= bonv;
        float oR[8];
#pragma unroll
        for (int j = 0; j < 8; ++j) oR[j] = (sR[j] * rstd * (j < 4 ? rw0[j] : rw1[j - 4]) + (j < 4 ? rb0[j] : rb1[j - 4]) + a[j]) * c[j];
        if (act) { u32x4 w; w.x = pack_bf16(oM[0], oM[1]); w.y = pack_bf16(oM[2], oM[3]); w.z = pack_bf16(oM[4], oM[5]); w.w = pack_bf16(oM[6], oM[7]);
            bf16_t* orow = dry ? (bf16_t*)(p.ws + WS_U) + (size_t)row * MIX_W : prow;
            *(u32x4*)(orow + ch) = w;
            w.x = pack_bf16(oR[0], oR[1]); w.y = pack_bf16(oR[2], oR[3]); w.z = pack_bf16(oR[4], oR[5]); w.w = pack_bf16(oR[6], oR[7]);
            *(u32x4*)(orow + W_M + ch) = w; }
    }
#undef CB_LOAD
}

__device__ __forceinline__ void phase_ln1_router(const Params& p, unsigned char* smem, int tile) {
    constexpr int TOK_LD = D_MODEL + 4;
    float* tok = (float*)smem;
    float* pe = tok + 16 * TOK_LD;
    float* pg = pe + 16 * NWAVES * 32;
    float* logit = pg + 16 * NWAVES * 4;
    int* hist = (int*)(logit + 16 * 40);
    int tid = threadIdx.x; OPAQUE(tid); const int lane = tid & 63, wid = tid >> 6, G = gridDim.x;
    const float* mod = (const float*)(p.ws + WS_MOD); const bf16_t* o = (const bf16_t*)(p.ws + WS_O);
    bf16_t* xm = (bf16_t*)(p.ws + WS_XM); bf16_t* x1 = (bf16_t*)(p.ws + WS_X1); int* eidx = (int*)(p.ws + WS_EIDX); float* ewt = (float*)(p.ws + WS_EWT); int* ccnt = (int*)(p.ws + WS_CCNT);
    constexpr int RKS = D_MODEL / (NWAVES * 32), NTE = (N_EXPERTS + 15) / 16;
    static_assert(D_MODEL % (NWAVES * 32) == 0 && N_EXPERTS <= 32 && N_GROUPS <= 4, "router tiling");
    const int l15 = lane & 15, lq = lane >> 4;
    bf16x8 wh[NTE + 1][RKS], wl[NTE + 1][RKS];
#pragma unroll
    for (int nt = 0; nt <= NTE; ++nt)
#pragma unroll
        for (int ks = 0; ks < RKS; ++ks) { float wv[8];
#pragma unroll
            for (int j = 0; j < 8; ++j) { const int k = wid * (RKS * 32) + ks * 32 + lq * 8 + j;
                if (nt < NTE) { const int e = nt * 16 + l15; wv[j] = (e < N_EXPERTS) ? p.rt_e[(size_t)k * N_EXPERTS + (e < N_EXPERTS ? e : 0)] : 0.f; }
                else wv[j] = (l15 < N_GROUPS) ? p.rt_g[(size_t)k * N_GROUPS + (l15 < N_GROUPS ? l15 : 0)] : 0.f; }
            split8(wv, wh[nt][ks], wl[nt][ks]); }
    if (tile == 0) for (int k = tid; k < D_MODEL; k += NTHREADS) xm[(size_t)NLAT * D_MODEL + k] = 0;
    __syncthreads();
    if (tid < 32) hist[tid] = 0;
    (void)G;
    const float eb_h = ((tid & 31) < N_EXPERTS) ? p.rt_e_b[(tid & 31) < N_EXPERTS ? (tid & 31) : 0] : 0.f, gb_h = ((tid & 31) < N_GROUPS) ? p.rt_g_b[(tid & 31) < N_GROUPS ? (tid & 31) : 0] : 0.f;
    f32x4 xn[2][NV4]; u32x2 on[2][NV4];
#define LN1_LOAD(itn) do { const int _r0 = tile * 256 + (itn) * 16 + wid * 2; _Pragma("unroll") for (int rr = 0; rr < 2; ++rr) _Pragma("unroll") for (int i = 0; i < NV4; ++i) { \
            const size_t ro = (size_t)(_r0 + rr) * D_MODEL + 4 * lane + 256 * i; xn[rr][i] = *(const f32x4*)(p.x + ro); on[rr][i] = *(const u32x2*)(o + ro); } } while (0)
    LN1_LOAD(0);
    for (int it = 0; it < 256 / 16; ++it) {
        const int rbase = tile * 256 + it * 16;
        LDS_BAR();
        {
            const int lr0 = wid * 2, row0 = rbase + lr0, b = row0 / SEQ;
            const float* m = mod + (size_t)b * 6 * D_MODEL;
            f32x4 v[2][NV4]; float s[2] = {0.f, 0.f};
#pragma unroll
            for (int rr = 0; rr < 2; ++rr)
#pragma unroll
                for (int i = 0; i < NV4; ++i) { const int k = 4 * lane + 256 * i; const size_t ro = (size_t)(row0 + rr) * D_MODEL + k;
                    const u32x2 ob = on[rr][i]; const f32x4 ov = (f32x4){bf2f((bf16_t)(ob.x & 0xffff)), bf2f((bf16_t)(ob.x >> 16)), bf2f((bf16_t)(ob.y & 0xffff)), bf2f((bf16_t)(ob.y >> 16))};
                    const f32x4 xv = xn[rr][i], g1 = *(const f32x4*)(m + 2 * D_MODEL + k);
                    v[rr][i] = xv * ALPHA + g1 * ov; s[rr] += (v[rr][i][0] + v[rr][i][1]) + (v[rr][i][2] + v[rr][i][3]); }
            float mu[2], rstd[2], q[2];
#pragma unroll
            for (int rr = 0; rr < 2; ++rr) mu[rr] = wave_sum(s[rr]) * (1.0f / D_MODEL);
#pragma unroll
            for (int rr = 0; rr < 2; ++rr) { q[rr] = 0.f;
#pragma unroll
                for (int i = 0; i < NV4; ++i) { const f32x4 dd = v[rr][i] - mu[rr]; q[rr] += (dd[0] * dd[0] + dd[1] * dd[1]) + (dd[2] * dd[2] + dd[3] * dd[3]); } }
#pragma unroll
            for (int rr = 0; rr < 2; ++rr) rstd[rr] = rsqrtf(wave_sum(q[rr]) * (1.0f / D_MODEL) + LN_EPS);
#pragma unroll
            for (int rr = 0; rr < 2; ++rr) { s[rr] = 0.f;
#pragma unroll
                for (int i = 0; i < NV4; ++i) { const int k = 4 * lane + 256 * i; v[rr][i] = (v[rr][i] - mu[rr]) * rstd[rr] * *(const f32x4*)(p.ln1_g + k) + *(const f32x4*)(p.ln1_b + k);
                    { u32x2 w; w.x = pack_bf16(v[rr][i][0], v[rr][i][1]); w.y = pack_bf16(v[rr][i][2], v[rr][i][3]); *(u32x2*)(x1 + (size_t)(row0 + rr) * D_MODEL + k) = w; }
                    s[rr] += (v[rr][i][0] + v[rr][i][1]) + (v[rr][i][2] + v[rr][i][3]); } }
#pragma unroll
            for (int rr = 0; rr < 2; ++rr) mu[rr] = wave_sum(s[rr]) * (1.0f / D_MODEL);
#pragma unroll
            for (int rr = 0; rr < 2; ++rr) { q[rr] = 0.f;
#pragma unroll
                for (int i = 0; i < NV4; ++i) { const f32x4 dd = v[rr][i] - mu[rr]; q[rr] += (dd[0] * dd[0] + dd[1] * dd[1]) + (dd[2] * dd[2] + dd[3] * dd[3]); } }
#pragma unroll
            for (int rr = 0; rr < 2; ++rr) rstd[rr] = rsqrtf(wave_sum(q[rr]) * (1.0f / D_MODEL) + LN_EPS);
#pragma unroll
            for (int rr = 0; rr < 2; ++rr)
#pragma unroll
                for (int i = 0; i < NV4; ++i) { const int k = 4 * lane + 256 * i; const f32x4 tv = (v[rr][i] - mu[rr]) * rstd[rr] * (*(const f32x4*)(m + 4 * D_MODEL + k) + 1.0f) + *(const f32x4*)(m + 3 * D_MODEL + k);
                    *(f32x4*)(tok + (lr0 + rr) * TOK_LD + k) = tv; u32x2 w; w.x = pack_bf16(tv[0], tv[1]); w.y = pack_bf16(tv[2], tv[3]); *(u32x2*)(xm + (size_t)(row0 + rr) * D_MODEL + k) = w; }
            LN1_LOAD(it + 1 < 256 / 16 ? it + 1 : it);
        }
        LDS_BAR();
        {
            f32x4 racc[NTE + 1];
#pragma unroll
            for (int nt = 0; nt <= NTE; ++nt) racc[nt] = (f32x4){0.f, 0.f, 0.f, 0.f};
#pragma unroll
            for (int ks = 0; ks < RKS; ++ks) { const float* tp = tok + l15 * TOK_LD + wid * (RKS * 32) + ks * 32 + lq * 8;
                const f32x4 t0 = *(const f32x4*)tp, t1 = *(const f32x4*)(tp + 4); const float xv[8] = {t0[0], t0[1], t0[2], t0[3], t1[0], t1[1], t1[2], t1[3]};
                bf16x8 ah, al; split8(xv, ah, al);
#pragma unroll
                for (int nt = 0; nt <= NTE; ++nt) { racc[nt] = MFMA16(al, wh[nt][ks], racc[nt]); racc[nt] = MFMA16(ah, wl[nt][ks], racc[nt]); racc[nt] = MFMA16(ah, wh[nt][ks], racc[nt]); } }
#pragma unroll
            for (int r = 0; r < 4; ++r) {
#pragma unroll
                for (int nt = 0; nt < NTE; ++nt) pe[((4 * lq + r) * NWAVES + wid) * 32 + nt * 16 + l15] = racc[nt][r];
                if (l15 < 4) pg[((4 * lq + r) * NWAVES + wid) * 4 + l15] = racc[NTE][r]; }
        }
        LDS_BAR();
        {   const int r = tid >> 5, e = tid & 31; float acc = 0.f, accg = 0.f;
#pragma unroll
            for (int w = 0; w < NWAVES; ++w) { acc += pe[(r * NWAVES + w) * 32 + e]; if (e < 4) accg += pg[(r * NWAVES + w) * 4 + e]; }
            if (e < N_EXPERTS) logit[r * 40 + 4 + e] = acc + eb_h;
            if (e < N_GROUPS) logit[r * 40 + e] = accg + gb_h; }
        LDS_BAR();
        if (tid < 16) {
            const float* lgt = logit + tid * 40; const int row = rbase + tid;
            int grp = 0; float mx = lgt[0];
            for (int gI = 1; gI < N_GROUPS; ++gI) if (lgt[gI] > mx) { mx = lgt[gI]; grp = gI; }
            float se = 0.f; for (int gI = 0; gI < N_GROUPS; ++gI) se += fexp(lgt[gI] - mx);
            const float p_top = 1.0f / se;
            const float* le = lgt + 4 + grp * E_PER_GROUP;
            int i0 = 0; for (int e = 1; e < E_PER_GROUP; ++e) if (le[e] > le[i0]) i0 = e;
            int i1 = (i0 == 0) ? 1 : 0; for (int e = 0; e < E_PER_GROUP; ++e) if (e != i0 && le[e] > le[i1]) i1 = e;
            const float e1 = fexp(le[i1] - le[i0]); const float w0 = 1.0f / (1.0f + e1), w1 = e1 / (1.0f + e1);
            const int ea = grp * E_PER_GROUP + i0, eb = grp * E_PER_GROUP + i1;
            eidx[2 * row] = ea; eidx[2 * row + 1] = eb; ewt[2 * row] = w0 * p_top; ewt[2 * row + 1] = w1 * p_top;
            atomicAdd(&hist[ea], 1); atomicAdd(&hist[eb], 1);
        }
    }
    __syncthreads();
    if (tid < N_EXPERTS) ccnt[tile * N_EXPERTS + tid] = hist[tid];
#undef LN1_LOAD
}

__device__ __forceinline__ void phase_route(const Params& p, unsigned char* smem) {
    int* tot = (int*)smem; int* pre = tot + 32; int* pstart = pre + 32; int* pend = pstart + 32; int* coff = pend + 32; int* run = coff + 32; int* wcnt = run + 32; int* psum = wcnt + NWAVES * 32; int* ppre = psum + 16 * 32;
    int tid = threadIdx.x; OPAQUE(tid); const int lane = tid & 63, wid = tid >> 6; const int G = gridDim.x;
    constexpr int NT = NLAT / 256, NP = 512;
    const int* eidx = (const int*)(p.ws + WS_EIDX); const float* ewt = (const float*)(p.ws + WS_EWT); const int* ccnt = (const int*)(p.ws + WS_CCNT);
    int* dest = (int*)(p.ws + WS_DEST); int* tokbuf = (int*)(p.ws + WS_TOKBUF); float* wbuf = (float*)(p.ws + WS_WBUF); int* blk_exp = (int*)(p.ws + WS_BLKEXP);
    const unsigned long long lt = (1ull << lane) - 1ull;
    for (int tile = blockIdx.x; tile < NT; tile += G) {
        __syncthreads();
        {
            constexpr int TPP = (NT + 15) / 16; const int e = tid & 31, part = tid >> 5; int sp = 0, pp2 = 0;
            if (e < N_EXPERTS) {
#pragma unroll 4
                for (int q = 0; q < TPP; ++q) { const int bb = part * TPP + q; const int cval = (bb < NT) ? ccnt[(bb < NT ? bb : 0) * N_EXPERTS + e] : 0; if (bb < tile) pp2 += cval; sp += cval; } }
            psum[part * 32 + e] = sp; ppre[part * 32 + e] = pp2;
        }
        __syncthreads();
        if (tid < N_EXPERTS) { int s2 = 0, pr = 0;
#pragma unroll
            for (int q = 0; q < 16; ++q) { s2 += psum[q * 32 + tid]; pr += ppre[q * 32 + tid]; }
            tot[tid] = s2; pre[tid] = pr; run[tid] = 0; }
        __syncthreads();
        if (tid == 0) { int s = 0; for (int e = 0; e < N_EXPERTS; ++e) { pstart[e] = s; s += (tot[e] + MOE_BLOCK - 1) / MOE_BLOCK * MOE_BLOCK; pend[e] = s; } }
        __syncthreads();
        if (tid < N_EXPERTS) coff[tid] = pstart[tid] + pre[tid];
        for (int base = 0; base < NP; base += NTHREADS) {
            const int i = base + tid; const bool valid = i < NP; const int pidx = tile * NP + (valid ? i : 0);
            const int e = valid ? eidx[pidx] : -1; int rk = 0;
            for (int ex = 0; ex < N_EXPERTS; ++ex) { const unsigned long long mk = BALLOT(e == ex); if (e == ex) rk = (int)POPCLL(mk & lt); if (lane == 0) wcnt[wid * 32 + ex] = (int)POPCLL(mk); }
            __syncthreads();
            if (valid) { int off = coff[e] + run[e]; for (int w = 0; w < wid; ++w) off += wcnt[w * 32 + e];
                const int dst = off + rk; dest[pidx] = dst; tokbuf[dst] = pidx >> 1; wbuf[dst] = ewt[pidx]; }
            __syncthreads();
            if (tid < N_EXPERTS) { int a2 = 0; for (int w = 0; w < NWAVES; ++w) a2 += wcnt[w * 32 + tid]; run[tid] += a2; }
            __syncthreads();
        }
        if (tile == 0) {
            for (int rb = tid; rb < MAX_RB; rb += NTHREADS) { int e = 0; while (e < N_EXPERTS - 1 && rb * MOE_BLOCK >= pend[e]) ++e; blk_exp[rb] = e; }
            if (tid == 0) blk_exp[MAX_RB] = pend[N_EXPERTS - 1];
        }
        for (int e = tile; e < N_EXPERTS; e += NT) for (int r = pstart[e] + tot[e] + tid; r < pend[e]; r += NTHREADS) { tokbuf[r] = NLAT; wbuf[r] = 0.f; }
    }
}

__device__ __forceinline__ void phase_final(const Params& p, bool dry) {
    int tid = threadIdx.x; OPAQUE(tid); const int lane = tid & 63, wid = tid >> 6;
    const float* mod = (const float*)(p.ws + WS_MOD); const bf16_t* ypair = (const bf16_t*)(p.ws + WS_YPAIR); const int* dest = (const int*)(p.ws + WS_DEST); const bf16_t* x1 = (const bf16_t*)(p.ws + WS_X1);
    float* ob = dry ? (float*)(p.ws + WS_HID) : p.out;
    const int stride = gridDim.x * NWAVES;
    int dn[2][2];
#define FN_DEST(ra) do { _Pragma("unroll") for (int rr = 0; rr < 2; ++rr) { const int _r = ((ra) + rr * stride < NLAT) ? (ra) + rr * stride : ((ra) < NLAT ? (ra) : 0); dn[rr][0] = dest[2 * _r]; dn[rr][1] = dest[2 * _r + 1]; } } while (0)
    FN_DEST(blockIdx.x * NWAVES + wid);
    for (int rowa = blockIdx.x * NWAVES + wid; rowa < NLAT; rowa += 2 * stride) {
        f32x4 v[2][NV4]; float s[2] = {0.f, 0.f}; int rows[2]; bool ok[2];
        const int dc[2][2] = {{dn[0][0], dn[0][1]}, {dn[1][0], dn[1][1]}};
        FN_DEST(rowa + 2 * stride);
#pragma unroll
        for (int rr = 0; rr < 2; ++rr) { rows[rr] = rowa + rr * stride; ok[rr] = rows[rr] < NLAT; const int row = ok[rr] ? rows[rr] : rowa;
            const int b = row / SEQ; const float* m = mod + (size_t)b * 6 * D_MODEL;
            const int p0 = dc[rr][0], p1 = dc[rr][1];
#pragma unroll
            for (int i = 0; i < NV4; ++i) { const int k = 4 * lane + 256 * i;
                const u32x2 ya = *(const u32x2*)(ypair + (size_t)p0 * D_MODEL + k), yb = *(const u32x2*)(ypair + (size_t)p1 * D_MODEL + k);
                f32x4 f; f[0] = bf2f((bf16_t)(ya.x & 0xffff)) + bf2f((bf16_t)(yb.x & 0xffff)); f[1] = bf2f((bf16_t)(ya.x >> 16)) + bf2f((bf16_t)(yb.x >> 16));
                f[2] = bf2f((bf16_t)(ya.y & 0xffff)) + bf2f((bf16_t)(yb.y & 0xffff)); f[3] = bf2f((bf16_t)(ya.y >> 16)) + bf2f((bf16_t)(yb.y >> 16));
                const u32x2 xb = *(const u32x2*)(x1 + (size_t)row * D_MODEL + k); const f32x4 x1v = (f32x4){bf2f((bf16_t)(xb.x & 0xffff)), bf2f((bf16_t)(xb.x >> 16)), bf2f((bf16_t)(xb.y & 0xffff)), bf2f((bf16_t)(xb.y >> 16))};
                v[rr][i] = x1v * ALPHA + *(const f32x4*)(m + 5 * D_MODEL + k) * f; s[rr] += (v[rr][i][0] + v[rr][i][1]) + (v[rr][i][2] + v[rr][i][3]); } }
        float mu[2], q[2], rstd[2];
#pragma unroll
        for (int rr = 0; rr < 2; ++rr) mu[rr] = wave_sum(s[rr]) * (1.0f / D_MODEL);
#pragma unroll
        for (int rr = 0; rr < 2; ++rr) { q[rr] = 0.f;
#pragma unroll
            for (int i = 0; i < NV4; ++i) { const f32x4 dd = v[rr][i] - mu[rr]; q[rr] += (dd[0] * dd[0] + dd[1] * dd[1]) + (dd[2] * dd[2] + dd[3] * dd[3]); } }
#pragma unroll
        for (int rr = 0; rr < 2; ++rr) rstd[rr] = rsqrtf(wave_sum(q[rr]) * (1.0f / D_MODEL) + LN_EPS);
#pragma unroll
        for (int rr = 0; rr < 2; ++rr) if (ok[rr]) {
#pragma unroll
            for (int i = 0; i < NV4; ++i) { const int k = 4 * lane + 256 * i; *(f32x4*)(ob + (size_t)rows[rr] * D_MODEL + k) = (v[rr][i] - mu[rr]) * rstd[rr] * *(const f32x4*)(p.ln2_g + k) + *(const f32x4*)(p.ln2_b + k); } }
    }
#undef FN_DEST
}

__global__ void __launch_bounds__(NTHREADS, 2) k_mega(Params p) {
    DYN_SMEM(smem);
    LAS unsigned char* lds = (LAS unsigned char*)smem;
    const int G = gridDim.x;
    bf16_t* Pt = (bf16_t*)(p.ws + WS_PT);
#ifndef HIP_EMU
    volatile LAS unsigned* bst = (volatile LAS unsigned*)(lds + LDS_BYTES - 16);
    if (threadIdx.x == 0) { bst[0] = 0u; bst[1] = 0u; bst[2] = 0u; bst[3] = 0u; }
    __syncthreads();
    const XcdBarrier gbar = xcd_barrier_post((unsigned*)(p.ws + WS_BAR), bst);
#endif
    for (int rep = 0; rep < REP_PRO; ++rep) phase_prologue(p, smem);
    GRID_SYNC();
    for (int rep = 0; rep < REP_LNMOD; ++rep) phase_ln_mod(p);
    GRID_SYNC();
    for (int rep = 0; rep < REP_GEMM * REP_G1; ++rep)
    {   pg8::Gemm g{(const bf16_t*)(p.ws + WS_H), (const bf16_t*)(p.ws + WS_WIN), D_MODEL, D_MODEL, nullptr, nullptr, 0, 0, 0, 0};
        pg8::StaticOrder S; S.init(NTOK, IN_PAD, G, (int)blockIdx.x);
        pg8::EpiInProj E{(bf16_t*)(p.ws + WS_PC), Pt};
        pg8::gemm_phase<pg8::EpiInProj, pg8::StaticOrder, false>(lds, g, S, E); }
    GRID_SYNC();
    for (int rep = 0; rep < REP_CONV; ++rep) phase_conv(p, smem, rep > 0);
    GRID_SYNC();
    for (int rep = 0; rep < REP_RWKV; ++rep) for (int job = blockIdx.x; job < 2 * BATCH * H_R; job += G) { if (job / (BATCH * H_R)) rwkv_job<1>(p, job, smem); else rwkv_job<0>(p, job, smem); }
    for (int rep = 0; rep < REP_MLSTM; ++rep) for (int job = blockIdx.x; job < 2 * BATCH * H_M; job += G) { if (job / (BATCH * H_M)) mlstm_job<1>(p, job, smem); else mlstm_job<0>(p, job, smem); }
    GRID_SYNC();
    {   pg8::Gemm g{Pt + T_LWB, (const bf16_t*)(p.ws + WS_GBT), GK, P2_LD, nullptr, nullptr, 0, SEQ / 256, T_ALL, CTX_LEN};
        pg8::OwnTile S{(int)blockIdx.x, G, NLAT / 256, W_R / 256};
        pg8::EpiBf16Mapped E{{Pt + T_MV, P2_LD, W_R, nullptr}};
        pg8::gemm_phase<pg8::EpiBf16Mapped, pg8::OwnTile, false>(lds, g, S, E); }
    __syncthreads();
    for (int tile = blockIdx.x; tile < NLAT / 256; tile += G) phase_combine(p, tile * 256, tile * 256 + 256, NWAVES, false);
    __syncthreads();
    {   pg8::Gemm g{Pt, (const bf16_t*)(p.ws + WS_WOUT), MIX_W, P2_LD, nullptr, nullptr, 0, SEQ / 256, T_ALL, CTX_LEN};
        pg8::OwnTile S{(int)blockIdx.x, G, NLAT / 256, D_MODEL / 256};
        pg8::EpiBf16 E{(bf16_t*)(p.ws + WS_O), D_MODEL, D_MODEL, nullptr};
        pg8::gemm_phase<pg8::EpiBf16, pg8::OwnTile, false>(lds, g, S, E); }
    __syncthreads();
    for (int tile = blockIdx.x; tile < NLAT / 256; tile += G) { phase_ln1_router(p, smem, tile); __syncthreads(); }
    GRID_SYNC();
    for (int rep = 0; rep < REP_ROUTE; ++rep) phase_route(p, smem);
    GRID_SYNC();
    const int* blk_exp = (const int*)(p.ws + WS_BLKEXP);
    const int rows_total = blk_exp[MAX_RB];
    for (int rep = 0; rep < REP_GEMM * REP_G4; ++rep)
    {   pg8::Gemm g{(const bf16_t*)(p.ws + WS_XM), (const bf16_t*)(p.ws + WS_WGU), D_MODEL, D_MODEL, (const int*)(p.ws + WS_TOKBUF), blk_exp, (size_t)2 * D_EXPERT * D_MODEL, 0, 0, 0};
        pg8::StaticOrder S; S.init(rows_total, 2 * D_EXPERT, G, (int)blockIdx.x);
        pg8::EpiSwiGLU E{(bf16_t*)(p.ws + WS_HID), D_EXPERT};
        pg8::gemm_phase<pg8::EpiSwiGLU, pg8::StaticOrder, true>(lds, g, S, E); }
    GRID_SYNC();
    for (int rep = 0; rep < REP_GEMM * REP_G5; ++rep)
    {   pg8::Gemm g{(const bf16_t*)(p.ws + WS_HID), (const bf16_t*)(p.ws + WS_WDN), D_EXPERT, D_EXPERT, nullptr, blk_exp, (size_t)D_MODEL * D_EXPERT, 0, 0, 0};
        pg8::StaticOrder S; S.init(rows_total, D_MODEL, G, (int)blockIdx.x);
        pg8::EpiBf16 E{(bf16_t*)(p.ws + WS_YPAIR), D_MODEL, D_MODEL, (const float*)(p.ws + WS_WBUF)};
        pg8::gemm_phase<pg8::EpiBf16, pg8::StaticOrder, false>(lds, g, S, E); }
    GRID_SYNC();
    for (int rep = 0; rep < REP_FINAL; ++rep) phase_final(p, rep + 1 < REP_FINAL);
}

#ifdef HIP_EMU
void emu_dbg(const char* name, const void* p, int is_bf16, size_t n);
#define DBG(name, p, bf, n) emu_dbg(name, p, bf, n)
#else
#define DBG(name, p, bf, n)
#endif

extern "C" void kernel_launch(void* const* d_in, const int* in_sizes, int n_in, void* d_out, int out_size, void* d_ws, size_t ws_size, hipStream_t stream) {
    (void)in_sizes; (void)n_in; (void)out_size; (void)ws_size;
    Params p{};
    const float** dst = (const float**)&p;
    for (int i = 0; i < 33; ++i) dst[i] = (const float*)d_in[i];
    p.out = (float*)d_out; p.ws = (unsigned char*)d_ws;
    static int grid_blocks = 0;
    if (!grid_blocks) {
        int dev = 0, cus = 0, per_cu = 0;
        (void)hipGetDevice(&dev); (void)hipDeviceGetAttribute(&cus, hipDeviceAttributeMultiprocessorCount, dev);
#ifndef HIP_EMU
        (void)hipFuncSetAttribute((const void*)k_mega, hipFuncAttributeMaxDynamicSharedMemorySize, LDS_BYTES);
#endif
        (void)hipOccupancyMaxActiveBlocksPerMultiprocessor(&per_cu, k_mega, NTHREADS, (size_t)LDS_BYTES);
        if (per_cu < 1) per_cu = 1;
        int g = cus;
        if (g > MAX_GRID) g = MAX_GRID;
        while (g > 1 && (NLAT % (16 * g)) != 0) --g;
        grid_blocks = g;
    }
#ifdef HIP_EMU
    EMU_LAUNCH_COOP(k_mega, dim3(grid_blocks), dim3(NTHREADS), LDS_BYTES, stream, p);
    unsigned char* ws = p.ws;
    DBG("mod", ws + WS_MOD, 0, (size_t)(BATCH + 1) * 6 * D_MODEL); DBG("h", ws + WS_H, 1, (size_t)NTOK * D_MODEL);
    {   auto gather_c = [&](const char* name, int col, int width) { bf16_t* tmp = (bf16_t*)malloc((size_t)NLAT * width * 2);
            for (int b = 0; b < BATCH; ++b) for (int l = 0; l < SEQ; ++l) for (int c2 = 0; c2 < width; ++c2) tmp[((size_t)b * SEQ + l) * width + c2] = ((const bf16_t*)(ws + WS_PC))[pc_off(col + c2, b * T_ALL + CTX_LEN + l)];
            DBG(name, tmp, 1, (size_t)NLAT * width); free(tmp); };
        auto gather_t = [&](const char* name, int col, int width) { bf16_t* tmp = (bf16_t*)malloc((size_t)NLAT * width * 2);
            for (int b = 0; b < BATCH; ++b) for (int l = 0; l < SEQ; ++l) memcpy(tmp + ((size_t)b * SEQ + l) * width, (const bf16_t*)(ws + WS_PT) + ((size_t)b * T_ALL + CTX_LEN + l) * P2_LD + col, (size_t)width * 2);
            DBG(name, tmp, 1, (size_t)NLAT * width); free(tmp); };
        gather_c("Yf", OFF_RR, W_R); gather_c("Yb", OFF_RK, W_R); gather_c("Hf", OFF_MQ, W_M); gather_c("Hb", OFF_MK, W_M); gather_t("mixed", 0, MIX_W); }
#else
    (void)hipMemsetAsync(p.ws + WS_BAR, 0, (size_t)3456 * 4, stream);
    void* args[] = {&p};
    hipError_t e = hipLaunchCooperativeKernel((void*)k_mega, dim3(grid_blocks), dim3(NTHREADS), args, (size_t)LDS_BYTES, stream);
    if (e != hipSuccess) fprintf(stderr, "cooperative launch failed: %s (grid %d)\n", hipGetErrorString(e), grid_blocks);
#endif
}
```
